# Optimizing an MI355X kernel written in HIP

```python
import math
import jax, jax.numpy as jnp
from jax import lax
import numpy as np

D_MODEL = 2048
BATCH = 4
SEQ = 4096
DEPTH = 2

CHUNK = 64
HEAD_DIM = 128
N_HEADS_A = D_MODEL // (2 * HEAD_DIM)
N_HEADS_B = D_MODEL // (2 * HEAD_DIM)
D_A = N_HEADS_A * HEAD_DIM
D_B = N_HEADS_B * HEAD_DIM
N_IDX_HEADS = 16
IDX_DIM = 64
TOPK_MAX = 256
ROPE_THETA = 10000.0
SPARSE_Q_BLOCK = 64
SB_Q_BLOCK = 128
D_FF = 5632
N_EXPERTS = 8
TOP_K_EXPERTS = 2
D_EXPERT = 7168
LN_EPS = 1e-5
DN_ALPHA = (2.0 * DEPTH) ** 0.25
DN_BETA = (8.0 * DEPTH) ** -0.25
N_DENSE = (DEPTH + 1) // 2
N_MOE = DEPTH // 2

_SPLIT_SIZES = (D_A, D_A, D_A,
                N_IDX_HEADS * IDX_DIM, IDX_DIM, N_IDX_HEADS,
                D_B, D_B, D_B,
                D_MODEL, D_MODEL)
IN_COLS = sum(_SPLIT_SIZES)
_OFFSETS = tuple(int(o) for o in np.cumsum((0,) + _SPLIT_SIZES))
SPLIT_POINTS = _OFFSETS[1:-1]
_VALUE_GROUPS = (2, 8)

kernel_name = 'hybrid_dsa_stickbreak_moe_deepnorm'

F32 = jnp.float32


def layer_norm(x, g, b):
    xf = x.astype(F32)
    mu = jnp.mean(xf, axis=-1, keepdims=True)
    var = jnp.mean(jnp.square(xf - mu), axis=-1, keepdims=True)
    y = (xf - mu) * lax.rsqrt(var + LN_EPS) * g.astype(F32) + b.astype(F32)
    return y.astype(x.dtype)


def rope_tables(positions, dim):
    inv_freq = ROPE_THETA ** (-jnp.arange(0, dim, 2, dtype=F32) / dim)
    ang = positions.astype(F32)[..., None] * inv_freq
    return jnp.cos(ang), jnp.sin(ang)


def apply_rope(x, cos, sin):
    xf = x.astype(F32)
    x1, x2 = jnp.split(xf, 2, axis=-1)
    c = cos[:, :, None, :]
    s = sin[:, :, None, :]
    return jnp.concatenate([x1 * c - x2 * s, x2 * c + x1 * s], axis=-1).astype(x.dtype)


def to_blocks(a, blk):
    b, s = a.shape[:2]
    return jnp.moveaxis(a.reshape((b, s // blk, blk) + a.shape[2:]), 1, 0)


def from_blocks(a):
    a = jnp.moveaxis(a, 0, 1)
    return a.reshape((a.shape[0], a.shape[1] * a.shape[2]) + a.shape[3:])


def dsa_sparse_attention(q, k, v, q_idx, k_idx, w_idx):
    bsz, s_len, n_h, dh = q.shape
    n_sel = min(TOPK_MAX, s_len // 4)
    key_chunk = jnp.arange(s_len) // CHUNK
    k_flat = k.reshape(bsz, s_len, n_h * dh)
    v_flat = v.reshape(bsz, s_len, n_h * dh)
    gather = jax.vmap(lambda table, idx: table[idx])
    scale = 1.0 / math.sqrt(dh)
    k_idx_f = k_idx.astype(F32)

    def block(args):
        qb, qib, wb, start = args
        t = start + jnp.arange(SPARSE_Q_BLOCK)
        q_chunk = t // CHUNK
        admissible = key_chunk[None, :] <= q_chunk[:, None]
        logits = jnp.einsum('bqhd,bsd->bqhs', qib.astype(F32), k_idx_f)
        score = jnp.einsum('bqh,bqhs->bqs', wb.astype(F32), jax.nn.relu(logits))
        score = jnp.where(admissible[None], score, -jnp.inf)
        _, sel = lax.top_k(score, n_sel)
        valid = (sel // CHUNK) <= q_chunk[None, :, None]
        kg = gather(k_flat, sel).reshape(bsz, SPARSE_Q_BLOCK, n_sel, n_h, dh)
        vg = gather(v_flat, sel).reshape(bsz, SPARSE_Q_BLOCK, n_sel, n_h, dh)
        s = jnp.einsum('bqhd,bqnhd->bqhn', qb.astype(F32), kg.astype(F32)) * scale
        s = jnp.where(valid[:, :, None, :], s, -jnp.inf)
        p = jax.nn.softmax(s, axis=-1)
        o = jnp.einsum('bqhn,bqnhd->bqhd', p, vg.astype(F32))
        return o.astype(q.dtype)

    starts = jnp.arange(s_len // SPARSE_Q_BLOCK) * SPARSE_Q_BLOCK
    out = lax.map(block, (to_blocks(q, SPARSE_Q_BLOCK), to_blocks(q_idx, SPARSE_Q_BLOCK),
                          to_blocks(w_idx, SPARSE_Q_BLOCK), starts))
    return from_blocks(out)


def stick_breaking_attention(q, k, v):
    bsz, s_len, n_h, dh = q.shape
    key_pos = jnp.arange(s_len)
    scale = 1.0 / math.sqrt(dh)
    k_f = k.astype(F32)
    v_f = v.astype(F32)

    def block(args):
        qb, start = args
        t = start + jnp.arange(SB_Q_BLOCK)
        strict = (key_pos[None, :] < t[:, None])[None, None]
        z = jnp.einsum('bqhd,bshd->bhqs', qb.astype(F32), k_f) * scale
        log_keep = jnp.where(strict, jax.nn.log_sigmoid(-z), 0.0)
        later = lax.cumsum(log_keep, axis=3, reverse=True) - log_keep
        a = jnp.where(strict, jnp.exp(jax.nn.log_sigmoid(z) + later), 0.0)
        o = jnp.einsum('bhqs,bshd->bqhd', a, v_f)
        return o.astype(q.dtype)

    starts = jnp.arange(s_len // SB_Q_BLOCK) * SB_Q_BLOCK
    out = lax.map(block, (to_blocks(q, SB_Q_BLOCK), starts))
    return from_blocks(out)


def hybrid_mixer(x, cos_h, sin_h, cos_i, sin_i, w_in, w_proj_a, w_proj_b, w_out):
    bsz, s_len, _ = x.shape
    h = jnp.einsum('bsd,dc->bsc', x, w_in)
    qa, ka, va, qi, ki, wi, qb, kb, vb, ga, gb = jnp.split(h, SPLIT_POINTS, axis=-1)
    heads = lambda t, n, d: t.reshape(bsz, s_len, n, d)
    qa = apply_rope(heads(qa, N_HEADS_A, HEAD_DIM), cos_h, sin_h)
    ka = apply_rope(heads(ka, N_HEADS_A, HEAD_DIM), cos_h, sin_h)
    va = heads(va, N_HEADS_A, HEAD_DIM)
    qi = apply_rope(heads(qi, N_IDX_HEADS, IDX_DIM), cos_i, sin_i)
    ki = apply_rope(ki[:, :, None, :], cos_i, sin_i)[:, :, 0, :]
    o_a = dsa_sparse_attention(qa, ka, va, qi, ki, wi).reshape(bsz, s_len, D_A)
    o_b = stick_breaking_attention(heads(qb, N_HEADS_B, HEAD_DIM), heads(kb, N_HEADS_B, HEAD_DIM),
                                   heads(vb, N_HEADS_B, HEAD_DIM)).reshape(bsz, s_len, D_B)
    merged = (jax.nn.sigmoid(ga) * jnp.einsum('bsc,cd->bsd', o_a, w_proj_a)
              + jax.nn.sigmoid(gb) * jnp.einsum('bsc,cd->bsd', o_b, w_proj_b))
    return jnp.einsum('bsd,de->bse', merged, w_out)


def swiglu(x, w_gate, w_up, w_down):
    return (jax.nn.silu(x @ w_gate) * (x @ w_up)) @ w_down


def moe_swiglu(x, router_w, w_gate, w_up, w_down):
    bsz, s_len, d = x.shape
    xt = x.reshape(bsz * s_len, d)
    logits = (xt @ router_w).astype(F32)
    top_val, top_idx = lax.top_k(logits, TOP_K_EXPERTS)
    gates = jax.nn.softmax(top_val, axis=-1)
    comb = jnp.sum(jax.nn.one_hot(top_idx, N_EXPERTS, dtype=F32) * gates[..., None], axis=1)
    y = jnp.zeros((bsz * s_len, d), F32)
    for e in range(N_EXPERTS):
        y = y + comb[:, e:e + 1] * swiglu(xt, w_gate[e], w_up[e], w_down[e]).astype(F32)
    return y.astype(x.dtype).reshape(bsz, s_len, d)


def setup_inputs(seed: int = 0) -> dict:
    key = jax.random.key(seed)
    ks = jax.random.split(key, 24)

    def normal(k, shape, fan_in, scale=1.0):
        return jax.random.normal(k, shape, F32) * (scale * fan_in ** -0.5)

    def gain(k, shape):
        return 1.0 + 0.02 * jax.random.normal(k, shape, F32)

    def bias(k, shape):
        return 0.02 * jax.random.normal(k, shape, F32)

    x = jax.random.normal(ks[0], (BATCH, SEQ, D_MODEL), F32)
    offsets = jax.random.randint(ks[1], (BATCH, 1), 0, 4096, dtype=jnp.int32)
    positions = offsets + jnp.arange(SEQ, dtype=jnp.int32)[None, :]
    col_scale = np.ones((IN_COLS,), np.float32)
    for g in _VALUE_GROUPS:
        col_scale[_OFFSETS[g]:_OFFSETS[g + 1]] = DN_BETA
    w_in = normal(ks[2], (DEPTH, D_MODEL, IN_COLS), D_MODEL) * jnp.asarray(col_scale)
    return {
        'x': x,
        'positions': positions,
        'ln_in_g': gain(ks[3], (D_MODEL,)),
        'ln_in_b': bias(ks[4], (D_MODEL,)),
        'w_in': w_in,
        'w_proj_a': normal(ks[5], (DEPTH, D_A, D_MODEL), D_A, DN_BETA),
        'w_proj_b': normal(ks[6], (DEPTH, D_B, D_MODEL), D_B, DN_BETA),
        'w_out': normal(ks[7], (DEPTH, D_MODEL, D_MODEL), D_MODEL, DN_BETA),
        'ln_mix_g': gain(ks[8], (DEPTH, D_MODEL)),
        'ln_mix_b': bias(ks[9], (DEPTH, D_MODEL)),
        'ffn_w_gate': normal(ks[10], (N_DENSE, D_MODEL, D_FF), D_MODEL),
        'ffn_w_up': normal(ks[11], (N_DENSE, D_MODEL, D_FF), D_MODEL),
        'ffn_w_down': normal(ks[12], (N_DENSE, D_FF, D_MODEL), D_FF, DN_BETA),
        'router_w': normal(ks[13], (N_MOE, D_MODEL, N_EXPERTS), D_MODEL),
        'moe_w_gate': normal(ks[14], (N_MOE, N_EXPERTS, D_MODEL, D_EXPERT), D_MODEL),
        'moe_w_up': normal(ks[15], (N_MOE, N_EXPERTS, D_MODEL, D_EXPERT), D_MODEL),
        'moe_w_down': normal(ks[16], (N_MOE, N_EXPERTS, D_EXPERT, D_MODEL), D_EXPERT, DN_BETA),
        'ln_ffn_g': gain(ks[17], (DEPTH, D_MODEL)),
        'ln_ffn_b': bias(ks[18], (DEPTH, D_MODEL)),
    }


def reference(x, positions, ln_in_g, ln_in_b, w_in, w_proj_a, w_proj_b, w_out, ln_mix_g, ln_mix_b,
              ffn_w_gate, ffn_w_up, ffn_w_down, router_w, moe_w_gate, moe_w_up, moe_w_down,
              ln_ffn_g, ln_ffn_b):
    cos_h, sin_h = rope_tables(positions, HEAD_DIM)
    cos_i, sin_i = rope_tables(positions, IDX_DIM)
    x = layer_norm(x, ln_in_g, ln_in_b)
    for layer in range(DEPTH):
        mix = hybrid_mixer(x, cos_h, sin_h, cos_i, sin_i, w_in[layer], w_proj_a[layer],
                           w_proj_b[layer], w_out[layer])
        x = layer_norm(DN_ALPHA * x + mix, ln_mix_g[layer], ln_mix_b[layer])
        i = layer // 2
        if layer % 2 == 0:
            f = swiglu(x, ffn_w_gate[i], ffn_w_up[i], ffn_w_down[i])
        else:
            f = moe_swiglu(x, router_w[i], moe_w_gate[i], moe_w_up[i], moe_w_down[i])
        x = layer_norm(DN_ALPHA * x + f, ln_ffn_g[layer], ln_ffn_b[layer])
    return x
```

```cpp
#include <hip/hip_runtime.h>
#include <cstdio>
#include <cstdint>

namespace pg8 {
#define PG8_LAS __attribute__((address_space(3)))
typedef unsigned short bf16_t;
typedef short bf16x8 __attribute__((ext_vector_type(8)));
typedef float f32x4 __attribute__((ext_vector_type(4)));
typedef unsigned u32x4 __attribute__((ext_vector_type(4)));
typedef unsigned u32x2 __attribute__((ext_vector_type(2)));
typedef float f32x2 __attribute__((ext_vector_type(2)));
constexpr int BM = 256, BK = 64, HALF = 128, HTB = HALF * BK * 2  , STAGE_BYTES = 8 * HTB, NXCD = 8, WGM = 8;

__host__ __device__ __forceinline__ int lds_byte(int r, int c) { const int st = (r >> 4) * 2 + (c >> 5), rr = r & 15, cc = c & 31, ob = rr * 64 + cc * 2; return st * 1024 + (ob ^ (((ob >> 9) & 1) << 5)); }
__host__ __device__ __forceinline__ void stage_rc(int b, int& R, int& C) { const int st = b / 1024, sb = b % 1024, swz = sb ^ (((sb >> 9) & 1) << 5); R = (st >> 1) * 16 + swz / 64; C = (st & 1) * 32 + (swz % 64) / 2; }
__host__ __device__ __forceinline__ int perm32(int rho) { const int n = rho >> 4, i = rho & 15; return 8 * (i >> 2) + 4 * n + (i & 3); }

struct Unit { int pm, pn, pb, koff, aux; };
struct Gemm { const void* A; const void* Bt; int M, N, Kb, Kx; };
typedef int v4i __attribute__((ext_vector_type(4)));
template <int OPK> struct AccSel { typedef f32x4 T; };
template <> struct AccSel<1> { typedef v4i T; };

struct StaticOrder {
    int nM, nN, nwg, G, c;
    __host__ __device__ void init(int M, int N, int G_, int c_) { nM = M / BM; nN = N / BM; nwg = nM * nN; G = G_; c = c_; }
    __host__ __device__ bool next(int i, Unit& u) const {
        const long L = (long)i * G + c; if (L >= nwg) return false;
        int wgid = (int)L; { const int q = nwg / NXCD, r = nwg % NXCD, xcd = wgid % NXCD, off = wgid / NXCD; wgid = (xcd < r ? xcd * (q + 1) : r * (q + 1) + (xcd - r) * q) + off; }
        const int nig = WGM * nN, gid = wgid / nig, fm = gid * WGM, gsz = (nM - fm) < WGM ? (nM - fm) : WGM;
        u.pm = fm + ((wgid % nig) % gsz); u.pn = (wgid % nig) / gsz; u.pb = u.pn; u.koff = 0; u.aux = 0; return true;
    }
};
struct GroupedOrder {
    int nM, nN, nwg, G, c; int toff[9];
    __device__ bool next(int i, Unit& u) const {
        const long L = (long)i * G + c; if (L >= nwg) return false;
        int wgid = (int)L; { const int q = nwg / NXCD, r = nwg % NXCD, xcd = wgid % NXCD, off = wgid / NXCD; wgid = (xcd < r ? xcd * (q + 1) : r * (q + 1) + (xcd - r) * q) + off; }
        const int nig = WGM * nN, gid = wgid / nig, fm = gid * WGM, gsz = (nM - fm) < WGM ? (nM - fm) : WGM;
        u.pm = fm + ((wgid % nig) % gsz); u.pn = (wgid % nig) / gsz;
        int e = 0;
#pragma unroll
        for (int k = 1; k < 8; ++k) e += (u.pm >= toff[k]) ? 1 : 0;
        u.pb = e * nN + u.pn; u.koff = 0; u.aux = 0; return true;
    }
};
struct SplitOrder {
    int pm0, nr, nN, nch, kbytes, nwg, G, c; int toff[9];
    __device__ bool next(int i, Unit& u) const {
        const long L = (long)i * G + c; if (L >= nwg) return false;
        const int l = (int)L, kch = l % nch, rest = l / nch, pn = rest % nN, pmr = rest / nN;
        u.pm = pm0 + pmr; u.pn = pn;
        int e = 0;
#pragma unroll
        for (int k = 1; k < 8; ++k) e += (u.pm >= toff[k]) ? 1 : 0;
        u.pb = e * nN + pn; u.koff = kch * kbytes; u.aux = kch * 8 + pmr; return true;
    }
};
struct EpiPartialF32 {
    static constexpr bool PF = false; static constexpr int NST = 32; static constexpr bool PERM = false; static constexpr int OPK = 0;
    float* P; int ldc;
    __device__ __forceinline__ void operator()(const f32x4 (&acc)[2][2][4][2], const Unit& u, int wr, int wc, int fr, int fq) const {
        const int row0 = wr * 64 + fr, col0 = u.pn * BM + wc * 32 + 4 * fq;
        float* base = P + ((size_t)(u.aux >> 3) * 2048 + (size_t)(u.aux & 7) * 256) * ldc;
#pragma unroll
        for (int ai = 0; ai < 2; ++ai)
#pragma unroll
            for (int m = 0; m < 4; ++m) { float* rowp = base + (size_t)(row0 + ai * HALF + m * 16) * ldc + col0;
#pragma unroll
                for (int bj = 0; bj < 2; ++bj)
#pragma unroll
                    for (int n = 0; n < 2; ++n) *(f32x4*)(rowp + bj * HALF + n * 16) = acc[ai][bj][m][n]; }
    }
};


__device__ __forceinline__ unsigned cvt_pk_bf16(float lo, float hi) { unsigned r; asm volatile("v_cvt_pk_bf16_f32 %0, %1, %2" : "=v"(r) : "v"(lo), "v"(hi)); return r; }
__device__ __forceinline__ float bf_lo(unsigned w) { return __uint_as_float(w << 16); }
__device__ __forceinline__ float bf_hi(unsigned w) { return __uint_as_float(w & 0xffff0000u); }
__device__ __forceinline__ float sigmoidf_fast(float x) { return __builtin_amdgcn_rcpf(1.0f + __builtin_amdgcn_exp2f(-1.4426950408889634f * x)); }

struct EpiNullI8 {
    static constexpr bool PF = false; static constexpr int NST = 0; static constexpr bool PERM = true; static constexpr int OPK = 1;
    __device__ __forceinline__ void operator()(const v4i (&acc)[2][2][4][2], const Unit& u, int wr, int wc, int fr, int fq) const {
        (void)u; (void)wr; (void)wc; (void)fr; (void)fq;
#pragma unroll
        for (int ai = 0; ai < 2; ++ai)
#pragma unroll
            for (int bj = 0; bj < 2; ++bj)
#pragma unroll
                for (int m = 0; m < 4; ++m)
#pragma unroll
                    for (int n = 0; n < 2; ++n) asm volatile("" :: "v"(acc[ai][bj][m][n]));
    }
};
struct EpiDummyStoreI8 {
    static constexpr bool PF = false; static constexpr int NST = 16; static constexpr bool PERM = true; static constexpr int OPK = 1;
    bf16_t* O;
    __device__ __forceinline__ void operator()(const v4i (&acc)[2][2][4][2], const Unit& u, int wr, int wc, int fr, int fq) const {
        const int row0 = u.pm * BM + wr * 64 + fr, col0 = (u.pn * BM + wc * 32 + 8 * fq) & 4095;
#pragma unroll
        for (int ai = 0; ai < 2; ++ai)
#pragma unroll
            for (int m = 0; m < 4; ++m) { bf16_t* rowp = O + (size_t)(row0 + ai * HALF + m * 16) * 4096 + col0;
#pragma unroll
                for (int bj = 0; bj < 2; ++bj) { const f32x4 v0 = __builtin_convertvector(acc[ai][bj][m][0], f32x4), v1 = __builtin_convertvector(acc[ai][bj][m][1], f32x4);
                    u32x4 w; w.x = cvt_pk_bf16(v0[0], v0[1]); w.y = cvt_pk_bf16(v0[2], v0[3]); w.z = cvt_pk_bf16(v1[0], v1[1]); w.w = cvt_pk_bf16(v1[2], v1[3]);
                    *(u32x4*)(rowp + bj * HALF) = w; } }
    }
};
struct EpiStoreBf16 {
    static constexpr bool PF = false; static constexpr int NST = 16; static constexpr bool PERM = true; static constexpr int OPK = 0;
    bf16_t* O; int ldc;
    __device__ __forceinline__ void operator()(const f32x4 (&acc)[2][2][4][2], const Unit& u, int wr, int wc, int fr, int fq) const {
        const int row0 = u.pm * BM + wr * 64 + fr, col0 = u.pn * BM + wc * 32 + 8 * fq;
#pragma unroll
        for (int ai = 0; ai < 2; ++ai)
#pragma unroll
            for (int m = 0; m < 4; ++m) { bf16_t* rowp = O + (size_t)(row0 + ai * HALF + m * 16) * ldc + col0;
#pragma unroll
                for (int bj = 0; bj < 2; ++bj) { const f32x4 v0 = acc[ai][bj][m][0], v1 = acc[ai][bj][m][1];
                    u32x4 w; w.x = cvt_pk_bf16(v0[0], v0[1]); w.y = cvt_pk_bf16(v0[2], v0[3]); w.z = cvt_pk_bf16(v1[0], v1[1]); w.w = cvt_pk_bf16(v1[2], v1[3]);
                    __builtin_nontemporal_store(w, (u32x4*)(rowp + bj * HALF)); } }
    }
};
struct EpiH {
    static constexpr bool PF = true;  static constexpr int NST = 16; static constexpr bool PERM = true; static constexpr int OPK = 1;
    bf16_t* __restrict__ O; int ldc; const float* __restrict__ ropeH; const float* __restrict__ ropeI; const float* __restrict__ sx; const float* __restrict__ swmax; unsigned* __restrict__ vmaxw;
    __device__ __forceinline__ const float* pf_row(const Unit& u) const { return sx + u.pm * BM; }
    __device__ __forceinline__ const float* pf_col(const Unit& u) const { return swmax + u.pb * BM; }
    __device__ __forceinline__ void operator()(const v4i (&acc)[2][2][4][2], const Unit& u, int wr, int wc, int fr, int fq) const { pf(acc, u, wr, wc, fr, fq, nullptr); }
    __device__ __forceinline__ void pf(const v4i (&acc)[2][2][4][2], const Unit& u, int wr, int wc, int fr, int fq, const PG8_LAS unsigned char* prm) const {
        const int row0 = u.pm * BM + wr * 64 + fr, col0 = u.pn * BM + wc * 32 + 8 * fq;
        const int pn = u.pn;
        const int mode = pn < 8 ? 1 : ((pn >= 12 && pn < 16) ? 2 : 0);
        const int vsel = (pn >= 8 && pn < 12) ? 0 : ((pn >= 24 && pn < 28) ? 1 : -1);
        float vam = 0.f;
        f32x4 cs[2][2];
#pragma unroll
        for (int bj = 0; bj < 2; ++bj)
#pragma unroll
            for (int n = 0; n < 2; ++n) cs[bj][n] = (prm ? *(const PG8_LAS f32x4*)(prm + 1024 + (wc * 32 + 8 * fq + bj * HALF + 4 * n) * 4) : *(const f32x4*)(swmax + u.pb * BM + wc * 32 + 8 * fq + bj * HALF + 4 * n)) * (1.0f / 127.0f);
        float rsv[8];
#pragma unroll
        for (int r8 = 0; r8 < 8; ++r8) rsv[r8] = prm ? *(const PG8_LAS float*)(prm + (wr * 64 + fr + (r8 >> 2) * HALF + (r8 & 3) * 16) * 4) : sx[row0 + (r8 >> 2) * HALF + (r8 & 3) * 16];
#pragma unroll
        for (int ai = 0; ai < 2; ++ai) {
            f32x4 t0v[4], t1v[4];
#pragma unroll
            for (int m = 0; m < 4; ++m) { t0v[m] = (f32x4){1.f, 0.f, 1.f, 0.f}; t1v[m] = t0v[m]; }
            if (mode == 1) {
#pragma unroll
                for (int m = 0; m < 4; ++m) { const float* tab = ropeH + ((size_t)(row0 + ai * HALF + m * 16) * 64 + 4 * (4 * wc + fq)) * 2; t0v[m] = *(const f32x4*)tab; t1v[m] = *(const f32x4*)(tab + 4); } }
            else if (mode == 2) {
#pragma unroll
                for (int m = 0; m < 4; ++m) { const float* tab = ropeI + ((size_t)(row0 + ai * HALF + m * 16) * 32 + 4 * (4 * (wc & 1) + fq)) * 2; t0v[m] = *(const f32x4*)tab; t1v[m] = *(const f32x4*)(tab + 4); } }
#pragma unroll
            for (int m = 0; m < 4; ++m) { const int row = row0 + ai * HALF + m * 16; bf16_t* rowp = O + (size_t)row * ldc + col0;
                const float rs = rsv[ai * 4 + m];
                const f32x4 t0 = t0v[m], t1 = t1v[m];
#pragma unroll
                for (int bj = 0; bj < 2; ++bj) { f32x4 v0 = __builtin_convertvector(acc[ai][bj][m][0], f32x4) * cs[bj][0] * rs, v1 = __builtin_convertvector(acc[ai][bj][m][1], f32x4) * cs[bj][1] * rs;
                    if (mode != 0) {
                        const f32x4 c = (f32x4){t0[0], t0[2], t1[0], t1[2]}, sn = (f32x4){t0[1], t0[3], t1[1], t1[3]};
                        const f32x4 y0 = v0 * c - v1 * sn, y1 = v1 * c + v0 * sn; v0 = y0; v1 = y1; }
                    if (vsel >= 0) { const f32x4 a0 = __builtin_elementwise_abs(v0), a1 = __builtin_elementwise_abs(v1); vam = fmaxf(vam, fmaxf(fmaxf(fmaxf(a0[0], a0[1]), fmaxf(a0[2], a0[3])), fmaxf(fmaxf(a1[0], a1[1]), fmaxf(a1[2], a1[3])))); }
                    u32x4 w; w.x = cvt_pk_bf16(v0[0], v0[1]); w.y = cvt_pk_bf16(v0[2], v0[3]); w.z = cvt_pk_bf16(v1[0], v1[1]); w.w = cvt_pk_bf16(v1[2], v1[3]);
                    __builtin_nontemporal_store(w, (u32x4*)(rowp + bj * HALF));     } }
        }
        if (vsel >= 0) {
#pragma unroll
            for (int o = 1; o < 64; o <<= 1) vam = fmaxf(vam, __shfl_xor(vam, o));
            if ((fr | fq) == 0) atomicMax(vmaxw + vsel, __float_as_uint(vam * 1.00390625f));
        }
    }
};
template <int MODE> struct EpiGate {
    static constexpr bool PF = false; static constexpr int NST = 16; static constexpr bool PERM = true; static constexpr int OPK = 1;
    bf16_t* __restrict__ O; int ldc; const bf16_t* __restrict__ Gt; int ldg; const float* __restrict__ amaxA; const float* __restrict__ swmax;
    __device__ __forceinline__ void operator()(const v4i (&acc)[2][2][4][2], const Unit& u, int wr, int wc, int fr, int fq) const {
        const int row0 = u.pm * BM + wr * 64 + fr, col0 = u.pn * BM + wc * 32 + 8 * fq;
        const float sa = *amaxA * (1.0f / (127.0f * 127.0f));
        f32x4 cs[2][2];
#pragma unroll
        for (int bj = 0; bj < 2; ++bj)
#pragma unroll
            for (int n = 0; n < 2; ++n) cs[bj][n] = *(const f32x4*)(swmax + col0 + bj * HALF + 4 * n) * sa;
        constexpr int GR = MODE == 1 ? 2 : 4;
#pragma unroll
        for (int grp = 0; grp < 8 / GR; ++grp) {
            u32x4 gq[GR][2], oq[GR][2];
#pragma unroll
            for (int k = 0; k < GR; ++k) { const int r8 = grp * GR + k; const size_t row = (size_t)(row0 + (r8 >> 2) * HALF + (r8 & 3) * 16);
#pragma unroll
                for (int bj = 0; bj < 2; ++bj) { gq[k][bj] = *(const u32x4*)(Gt + row * ldg + col0 + bj * HALF); if (MODE == 1) oq[k][bj] = *(const u32x4*)(O + row * ldc + col0 + bj * HALF); } }
#pragma unroll
            for (int k = 0; k < GR; ++k) { const int r8 = grp * GR + k, ai = r8 >> 2, m = r8 & 3; const size_t row = (size_t)(row0 + ai * HALF + m * 16); bf16_t* rowp = O + row * ldc + col0;
#pragma unroll
                for (int bj = 0; bj < 2; ++bj) { const f32x4 v0 = __builtin_convertvector(acc[ai][bj][m][0], f32x4) * cs[bj][0], v1 = __builtin_convertvector(acc[ai][bj][m][1], f32x4) * cs[bj][1];
                    const u32x4 g = gq[k][bj];
                    float r[8];
                    r[0] = sigmoidf_fast(bf_lo(g.x)) * v0[0]; r[1] = sigmoidf_fast(bf_hi(g.x)) * v0[1]; r[2] = sigmoidf_fast(bf_lo(g.y)) * v0[2]; r[3] = sigmoidf_fast(bf_hi(g.y)) * v0[3];
                    r[4] = sigmoidf_fast(bf_lo(g.z)) * v1[0]; r[5] = sigmoidf_fast(bf_hi(g.z)) * v1[1]; r[6] = sigmoidf_fast(bf_lo(g.w)) * v1[2]; r[7] = sigmoidf_fast(bf_hi(g.w)) * v1[3];
                    if (MODE == 1) { const u32x4 o = oq[k][bj];
                        r[0] += bf_lo(o.x); r[1] += bf_hi(o.x); r[2] += bf_lo(o.y); r[3] += bf_hi(o.y); r[4] += bf_lo(o.z); r[5] += bf_hi(o.z); r[6] += bf_lo(o.w); r[7] += bf_hi(o.w); }
                    u32x4 w; w.x = cvt_pk_bf16(r[0], r[1]); w.y = cvt_pk_bf16(r[2], r[3]); w.z = cvt_pk_bf16(r[4], r[5]); w.w = cvt_pk_bf16(r[6], r[7]);
                    *(u32x4*)(rowp + bj * HALF) = w; } }
            asm volatile("" ::: "memory");
        }
    }
};
__device__ __forceinline__ const void* ldptr(volatile PG8_LAS unsigned* tab, int k) {
    const unsigned lo = __builtin_amdgcn_readfirstlane(tab[2 * k]), hi = __builtin_amdgcn_readfirstlane(tab[2 * k + 1]);
    return (const void*)(const __attribute__((address_space(1))) void*)(((unsigned long long)hi << 32) | lo);
}
template <bool INF32> struct EpiResid {
    static constexpr bool PF = false; static constexpr int NST = 16; static constexpr bool PERM = true; static constexpr int OPK = 0;
    volatile PG8_LAS unsigned* pt; int k_xin, k_xout, k_stats, k_g, k_b, ldc; float alpha;
    __device__ __forceinline__ void operator()(const f32x4 (&acc)[2][2][4][2], const Unit& u, int wr, int wc, int fr, int fq) const {
        const void* __restrict__ Xin = ldptr(pt, k_xin); bf16_t* __restrict__ Xout = (bf16_t*)ldptr(pt, k_xout); const float* __restrict__ stats = (const float*)ldptr(pt, k_stats);
        const float* __restrict__ g = (const float*)ldptr(pt, k_g); const float* __restrict__ b = (const float*)ldptr(pt, k_b);
        const int row0 = u.pm * BM + wr * 64 + fr, col0 = u.pn * BM + wc * 32 + 8 * fq;
        f32x4 gv[2][2], bv[2][2];
#pragma unroll
        for (int bj = 0; bj < 2; ++bj)
#pragma unroll
            for (int n = 0; n < 2; ++n) { gv[bj][n] = *(const f32x4*)(g + col0 + bj * HALF + 4 * n) * alpha; bv[bj][n] = *(const f32x4*)(b + col0 + bj * HALF + 4 * n) * alpha; }
#pragma unroll
        for (int am = 0; am < 4; ++am) {
            const int ai = am >> 1;
            f32x4 x[2][2][2]; float mu[2], rs[2];
#pragma unroll
            for (int mm = 0; mm < 2; ++mm) { const int m = (am & 1) * 2 + mm; const size_t row = (size_t)(row0 + ai * HALF + m * 16);
                const f32x2 st = *(const f32x2*)(stats + 2 * row); mu[mm] = st.x; rs[mm] = st.y;
#pragma unroll
                for (int bj = 0; bj < 2; ++bj) {
                    if constexpr (INF32) { const float* ip = (const float*)Xin + row * ldc + col0 + bj * HALF; x[mm][bj][0] = *(const f32x4*)ip; x[mm][bj][1] = *(const f32x4*)(ip + 4); }
                    else { const u32x4 w = *(const u32x4*)((const bf16_t*)Xin + row * ldc + col0 + bj * HALF);
                           x[mm][bj][0] = (f32x4){bf_lo(w.x), bf_hi(w.x), bf_lo(w.y), bf_hi(w.y)}; x[mm][bj][1] = (f32x4){bf_lo(w.z), bf_hi(w.z), bf_lo(w.w), bf_hi(w.w)}; } } }
#pragma unroll
            for (int mm = 0; mm < 2; ++mm) { const int m = (am & 1) * 2 + mm; const size_t row = (size_t)(row0 + ai * HALF + m * 16); bf16_t* op = Xout + row * ldc + col0;
#pragma unroll
                for (int bj = 0; bj < 2; ++bj) { const f32x4 y0 = (x[mm][bj][0] - mu[mm]) * rs[mm] * gv[bj][0] + bv[bj][0] + acc[ai][bj][m][0], y1 = (x[mm][bj][1] - mu[mm]) * rs[mm] * gv[bj][1] + bv[bj][1] + acc[ai][bj][m][1];
                    u32x4 w; w.x = cvt_pk_bf16(y0[0], y0[1]); w.y = cvt_pk_bf16(y0[2], y0[3]); w.z = cvt_pk_bf16(y1[0], y1[1]); w.w = cvt_pk_bf16(y1[2], y1[3]);
                    *(u32x4*)(op + bj * HALF) = w; } }
            asm volatile("" ::: "memory");
        }
    }
};
struct EpiSwiglu {
    static constexpr bool PF = true; static constexpr int NST = 8; static constexpr bool PERM = true; static constexpr int OPK = 1;
    bf16_t* __restrict__ O; int ldc; const float* __restrict__ sx; const float* __restrict__ swmax;
    __device__ __forceinline__ const float* pf_row(const Unit& u) const { return sx + u.pm * BM; }
    __device__ __forceinline__ const float* pf_col(const Unit& u) const { return swmax + u.pb * BM; }
    __device__ __forceinline__ void operator()(const v4i (&acc)[2][2][4][2], const Unit& u, int wr, int wc, int fr, int fq) const { pf(acc, u, wr, wc, fr, fq, nullptr); }
    __device__ __forceinline__ void pf(const v4i (&acc)[2][2][4][2], const Unit& u, int wr, int wc, int fr, int fq, const PG8_LAS unsigned char* prm) const {
        const int row0 = u.pm * BM + wr * 64 + fr, col0 = u.pn * HALF + wc * 32 + 8 * fq;
        f32x4 cs[2][2];
#pragma unroll
        for (int bj = 0; bj < 2; ++bj)
#pragma unroll
            for (int n = 0; n < 2; ++n) cs[bj][n] = (prm ? *(const PG8_LAS f32x4*)(prm + 1024 + (wc * 32 + 8 * fq + bj * HALF + 4 * n) * 4) : *(const f32x4*)(swmax + u.pb * BM + wc * 32 + 8 * fq + bj * HALF + 4 * n)) * (1.0f / 127.0f);
        float rsv[8];
#pragma unroll
        for (int r8 = 0; r8 < 8; ++r8) rsv[r8] = prm ? *(const PG8_LAS float*)(prm + (wr * 64 + fr + (r8 >> 2) * HALF + (r8 & 3) * 16) * 4) : sx[row0 + (r8 >> 2) * HALF + (r8 & 3) * 16];
#pragma unroll
        for (int ai = 0; ai < 2; ++ai)
#pragma unroll
            for (int m = 0; m < 4; ++m) { const int row = row0 + ai * HALF + m * 16; bf16_t* rowp = O + (size_t)row * ldc + col0;
                const float rs = rsv[ai * 4 + m];
                float r[8];
#pragma unroll
                for (int n = 0; n < 2; ++n) { const f32x4 gv = __builtin_convertvector(acc[ai][0][m][n], f32x4) * cs[0][n] * rs, uv = __builtin_convertvector(acc[ai][1][m][n], f32x4) * cs[1][n] * rs;
#pragma unroll
                    for (int j = 0; j < 4; ++j) r[4 * n + j] = gv[j] * sigmoidf_fast(gv[j]) * uv[j]; }
                u32x4 w; w.x = cvt_pk_bf16(r[0], r[1]); w.y = cvt_pk_bf16(r[2], r[3]); w.z = cvt_pk_bf16(r[4], r[5]); w.w = cvt_pk_bf16(r[6], r[7]);
                __builtin_nontemporal_store(w, (u32x4*)rowp); }
    }
};

__device__ __forceinline__ int opqv(int v) { asm volatile("" : "+v"(v)); return v; }
template <class Epi, class Sched, bool ALIGN_EPI = false, bool SP2 = false>
__device__ __forceinline__ void gemm_phase(PG8_LAS unsigned char* lds, const Gemm g, const Sched& S, const Epi& E) {
    const int tid = opqv(threadIdx.x), wid = __builtin_amdgcn_readfirstlane(tid >> 6), lane = tid & 63, wr = wid >> 2, wc = wid & 3, fr = lane & 15, fq = lane >> 4;
    const int Kb = g.Kb, nt = g.Kx / 128; constexpr int OPK = Epi::OPK; typedef typename AccSel<OPK>::T acc_t;
    unsigned voffA[2], voffB[2];
#pragma unroll
    for (int i = 0; i < 2; ++i) { int R, C; stage_rc(tid * 16 + i * 8192, R, C); const int Rb = Epi::PERM ? ((R & ~31) + perm32(R & 31)) : R;
        voffA[i] = (unsigned)(R * Kb + C * 2); voffB[i] = (unsigned)(Rb * Kb + C * 2); }
    const size_t kstep = (size_t)(BK * 2);
    const size_t hstep = (size_t)HALF * Kb;
    const size_t tstep = 2 * hstep;
    const unsigned ldsw = (unsigned)wid * 1024u;
    const int aoff = lds_byte(wr * 64 + fr, fq * 8), boff = lds_byte(wc * 32 + fr, fq * 8);
#define PG8_SA(b, h) (((b) * 2 + (h)) * HTB)
#define PG8_SB(b, h) ((4 + (b) * 2 + (h)) * HTB)
#define PG8_STAGE(bufoff, gbase, voff) do { _Pragma("unroll") for (int _i = 0; _i < 2; ++_i) \
        __builtin_amdgcn_global_load_lds((const unsigned*)((const char*)(gbase) + (voff)[_i]), (PG8_LAS unsigned*)(lds + (bufoff) + ldsw + _i * 8192), 16, 0, 0); } while (0)
#define PG8_LDA(dst, b, h) do { _Pragma("unroll") for (int m = 0; m < 4; ++m) _Pragma("unroll") for (int k = 0; k < 2; ++k) dst[m][k] = *(const PG8_LAS bf16x8*)(lds + PG8_SA(b, h) + aoff + m * 2048 + k * 1024); } while (0)
#define PG8_LDB(dst, b, h) do { _Pragma("unroll") for (int n = 0; n < 2; ++n) _Pragma("unroll") for (int k = 0; k < 2; ++k) dst[n][k] = *(const PG8_LAS bf16x8*)(lds + PG8_SB(b, h) + boff + n * 2048 + k * 1024); } while (0)
#define PG8_MMA(ai, bj, At, Bt) do { __builtin_amdgcn_s_setprio(1); _Pragma("unroll") for (int m = 0; m < 4; ++m) _Pragma("unroll") for (int n = 0; n < 2; ++n) _Pragma("unroll") for (int k = 0; k < 2; ++k) { \
        if constexpr (OPK == 0) acc[ai][bj][m][n] = __builtin_bit_cast(acc_t, __builtin_amdgcn_mfma_f32_16x16x32_bf16(Bt[n][k], At[m][k], __builtin_bit_cast(f32x4, acc[ai][bj][m][n]), 0, 0, 0)); \
        else acc[ai][bj][m][n] = __builtin_bit_cast(acc_t, __builtin_amdgcn_mfma_i32_16x16x64_i8(__builtin_bit_cast(v4i, Bt[n][k]), __builtin_bit_cast(v4i, At[m][k]), __builtin_bit_cast(v4i, acc[ai][bj][m][n]), 0, 0, 0)); } \
        __builtin_amdgcn_s_setprio(0); } while (0)
#define PG8_WAIT_V(n) asm volatile("s_waitcnt vmcnt(" #n ")" ::: "memory")
#define PG8_WAIT_L(n) asm volatile("s_waitcnt lgkmcnt(" #n ")" ::: "memory")
#define PG8_BAR __builtin_amdgcn_s_barrier()
#define PG8_SCHED __builtin_amdgcn_sched_barrier(0)
    Unit cur, nxt; int ui = 0;
    if (!S.next(0, cur)) return;
    constexpr int PF_OFF = 139584;
#define PG8_PF_ISSUE(U, BUFI) do { if constexpr (Epi::PF) { \
        const float* src_ = (wid < 4 ? E.pf_row(U) + wid * 64 : E.pf_col(U) + (wid - 4) * 64) + lane; \
        __builtin_amdgcn_global_load_lds((const unsigned*)src_, (PG8_LAS unsigned*)(lds + PF_OFF + (BUFI) * 2048 + (wid < 4 ? wid * 256 : 1024 + (wid - 4) * 256)), 4, 0, 0); } } while (0)
    PG8_PF_ISSUE(cur, 0);
    acc_t acc[2][2][4][2];
#pragma unroll
    for (int a = 0; a < 2; ++a)
#pragma unroll
        for (int b = 0; b < 2; ++b)
#pragma unroll
            for (int m = 0; m < 4; ++m)
#pragma unroll
                for (int n = 0; n < 2; ++n) acc[a][b][m][n] = acc_t{};
    bf16x8 At[4][2], B0[2][2], B1[2][2];
    const char* cA = (const char*)g.A + (size_t)cur.pm * tstep + cur.koff; const char* cB = (const char*)g.Bt + (size_t)cur.pb * tstep + cur.koff;
    if constexpr (SP2) {
        PG8_STAGE(PG8_SB(0, 0), cB, voffB); PG8_STAGE(PG8_SB(0, 1), cB + hstep, voffB); PG8_STAGE(PG8_SA(0, 0), cA, voffA); PG8_STAGE(PG8_SA(0, 1), cA + hstep, voffA);
        if (wr == 1) PG8_BAR;
        PG8_WAIT_V(2); PG8_BAR;
        PG8_STAGE(PG8_SB(1, 0), cB + kstep, voffB); PG8_STAGE(PG8_SA(1, 0), cA + kstep, voffA); PG8_STAGE(PG8_SB(1, 1), cB + hstep + kstep, voffB);
        PG8_WAIT_V(6); PG8_BAR;
    } else {
        PG8_STAGE(PG8_SB(0, 0), cB, voffB); PG8_STAGE(PG8_SA(0, 0), cA, voffA); PG8_STAGE(PG8_SB(0, 1), cB + hstep, voffB); PG8_STAGE(PG8_SA(0, 1), cA + hstep, voffA);
        if (wr == 1) PG8_BAR;
        PG8_WAIT_V(4); PG8_BAR;
        PG8_STAGE(PG8_SB(1, 0), cB + kstep, voffB); PG8_STAGE(PG8_SA(1, 0), cA + kstep, voffA); PG8_STAGE(PG8_SB(1, 1), cB + hstep + kstep, voffB);
        PG8_WAIT_V(6); PG8_BAR;
    }
    for (;;) {
        const bool has_next = S.next(ui + 1, nxt);
        const char* nA = has_next ? (const char*)g.A + (size_t)nxt.pm * tstep + nxt.koff : cA; const char* nB = has_next ? (const char*)g.Bt + (size_t)nxt.pb * tstep + nxt.koff : cB;
#define PG8_KITER_SP2(WV) do { \
            PG8_LDB(B0, 0, 0); PG8_LDB(B1, 0, 1); PG8_SCHED; PG8_LDA(At, 0, 0); PG8_STAGE(PG8_SA(1, 1), a1 + hstep, voffA); \
            WV; PG8_WAIT_L(0); PG8_BAR; PG8_MMA(0, 0, At, B0); PG8_MMA(0, 1, At, B1); PG8_BAR; PG8_SCHED; \
            PG8_LDA(At, 0, 1); PG8_STAGE(PG8_SB(0, 0), b2, voffB); PG8_STAGE(PG8_SB(0, 1), b2 + hstep, voffB); PG8_STAGE(PG8_SA(0, 0), a2, voffA); \
            WV; PG8_WAIT_L(0); PG8_BAR; PG8_MMA(1, 0, At, B0); PG8_MMA(1, 1, At, B1); PG8_BAR; PG8_SCHED; \
            PG8_LDB(B0, 1, 0); PG8_LDB(B1, 1, 1); PG8_SCHED; PG8_LDA(At, 1, 0); PG8_STAGE(PG8_SA(0, 1), a2 + hstep, voffA); \
            PG8_WAIT_V(8); PG8_WAIT_L(0); PG8_BAR; PG8_MMA(0, 0, At, B0); PG8_MMA(0, 1, At, B1); PG8_BAR; PG8_SCHED; \
            PG8_LDA(At, 1, 1); PG8_STAGE(PG8_SB(1, 0), b3, voffB); PG8_STAGE(PG8_SB(1, 1), b3 + hstep, voffB); PG8_STAGE(PG8_SA(1, 0), a3, voffA); \
            PG8_WAIT_V(8); PG8_WAIT_L(0); PG8_BAR; PG8_MMA(1, 0, At, B0); PG8_MMA(1, 1, At, B1); PG8_BAR; PG8_SCHED; } while (0)
#define PG8_WV_SP2 asm volatile("s_cmp_eq_u32 %0, 0\n\ts_cbranch_scc1 .Lwv8_%=\n\ts_waitcnt vmcnt(%1)\n\ts_branch .Lwvx_%=\n.Lwv8_%=:\n\ts_waitcnt vmcnt(8)\n.Lwvx_%=:" :: "s"(rlx), "n"(8 + Epi::NST) : "memory", "scc")
        for (int t = 0; t < nt; t += 2) {
            const bool last = (t == nt - 2); const int rlx = __builtin_amdgcn_readfirstlane((SP2 && Epi::NST > 0 && ui > 0 && t == 0 && nt > 2) ? 1 : 0); (void)rlx;
            const char* a1 = cA + (size_t)(t + 1) * kstep;
            const char* a2 = last ? nA : cA + (size_t)(t + 2) * kstep; const char* b2 = last ? nB : cB + (size_t)(t + 2) * kstep;
            const char* a3 = a2 + kstep; const char* b3 = b2 + kstep;
            if constexpr (SP2) {
            PG8_KITER_SP2(PG8_WV_SP2);
            } else {
            PG8_LDB(B0, 0, 0); PG8_SCHED; PG8_LDA(At, 0, 0); PG8_STAGE(PG8_SA(1, 1), a1 + hstep, voffA);
            PG8_WAIT_L(8); PG8_BAR; PG8_WAIT_L(0); PG8_MMA(0, 0, At, B0); PG8_BAR; PG8_SCHED;
            PG8_LDB(B1, 0, 1); PG8_STAGE(PG8_SB(0, 0), b2, voffB);
            PG8_BAR; PG8_WAIT_L(0); PG8_MMA(0, 1, At, B1); PG8_BAR;
            PG8_LDA(At, 0, 1); PG8_STAGE(PG8_SA(0, 0), a2, voffA);
            PG8_BAR; PG8_WAIT_L(0); PG8_MMA(1, 0, At, B0); PG8_BAR; PG8_SCHED;
            PG8_STAGE(PG8_SB(0, 1), b2 + hstep, voffB);
            PG8_WAIT_V(6); PG8_BAR; PG8_MMA(1, 1, At, B1); PG8_BAR;
            PG8_LDB(B0, 1, 0); PG8_SCHED; PG8_LDA(At, 1, 0); PG8_STAGE(PG8_SA(0, 1), a2 + hstep, voffA);
            PG8_WAIT_L(8); PG8_BAR; PG8_WAIT_L(0); PG8_MMA(0, 0, At, B0); PG8_BAR; PG8_SCHED;
            PG8_LDB(B1, 1, 1); PG8_STAGE(PG8_SB(1, 0), b3, voffB);
            PG8_BAR; PG8_WAIT_L(0); PG8_MMA(0, 1, At, B1); PG8_BAR;
            PG8_LDA(At, 1, 1); PG8_STAGE(PG8_SA(1, 0), a3, voffA);
            PG8_BAR; PG8_WAIT_L(0); PG8_MMA(1, 0, At, B0); PG8_BAR; PG8_SCHED;
            PG8_STAGE(PG8_SB(1, 1), b3 + hstep, voffB);
            PG8_WAIT_V(6); PG8_BAR; PG8_MMA(1, 1, At, B1); PG8_BAR;
            }
        }
        if constexpr (ALIGN_EPI) { if (wr == 0) PG8_BAR; }
        if constexpr (Epi::PF) E.pf(acc, cur, wr, wc, fr, fq, lds + PF_OFF + (ui & 1) * 2048); else E(acc, cur, wr, wc, fr, fq);
        if (!has_next) break;
        PG8_PF_ISSUE(nxt, (ui + 1) & 1);
#pragma unroll
        for (int a = 0; a < 2; ++a)
#pragma unroll
            for (int b = 0; b < 2; ++b)
#pragma unroll
                for (int m = 0; m < 4; ++m)
#pragma unroll
                    for (int n = 0; n < 2; ++n) acc[a][b][m][n] = acc_t{};
        cur = nxt; cA = nA; cB = nB; ++ui;
        if constexpr (ALIGN_EPI) { if (wr == 1) PG8_BAR; }
    }
    PG8_WAIT_V(0);
    if constexpr (!ALIGN_EPI) { if (wr == 0) PG8_BAR; }
    PG8_BAR;
#undef PG8_KITER_SP2
#undef PG8_PF_ISSUE
#undef PG8_WV_SP2
#undef PG8_SA
#undef PG8_SB
#undef PG8_STAGE
#undef PG8_LDA
#undef PG8_LDB
#undef PG8_MMA
#undef PG8_WAIT_V
#undef PG8_WAIT_L
#undef PG8_BAR
#undef PG8_SCHED
}
}
constexpr int NWAVES = 8;
constexpr int BATCH = 4, SEQ = 4096, DM = 2048, MTOK = BATCH * SEQ;
constexpr int HD = 128, NHA = 8, NIH = 16, IDXD = 64, CHUNK = 64, TOPK = 256;
constexpr int DFF = 5632, NEXP = 8, DEXP = 7168;
constexpr int INCOLS = 11344, LDH = 11520;
constexpr int C_QA = 0, C_KA = 1024, C_VA = 2048, C_QI = 3072, C_QB = 4096, C_KB = 5120, C_VB = 6144, C_GA = 7168, C_GB = 9216, C_KI = 11264, C_WI = 11328;
constexpr float LN_EPS = 1e-5f;
constexpr float DN_ALPHA = 1.4142135623730951f;
constexpr int MAXSLOT = 2 * MTOK + NEXP * 256;

#define GAS __attribute__((address_space(1)))
#define LAS __attribute__((address_space(3)))
typedef unsigned short bf16;
typedef unsigned v4u __attribute__((ext_vector_type(4)));
typedef unsigned v2u __attribute__((ext_vector_type(2)));
typedef float f32x4 __attribute__((ext_vector_type(4)));
typedef float f32x16 __attribute__((ext_vector_type(16)));
typedef float f32x2v __attribute__((ext_vector_type(2)));
typedef short bf16x8 __attribute__((ext_vector_type(8)));
typedef short s16x4 __attribute__((ext_vector_type(4)));
typedef GAS unsigned gu32;
#define RLX_AGENT __ATOMIC_RELAXED, __HIP_MEMORY_SCOPE_AGENT
#define LDS_WAIT() do { __builtin_amdgcn_s_waitcnt(0xC07F); asm volatile("" ::: "memory"); } while (0)
#define VM_WAIT() do { __builtin_amdgcn_s_waitcnt(0x0F70); asm volatile("" ::: "memory"); } while (0)
#define SBAR() __builtin_amdgcn_sched_barrier(0)
__device__ __forceinline__ unsigned f2bf(float f) { unsigned u = __builtin_bit_cast(unsigned, f); return (u + 0x7fffu + ((u >> 16) & 1u)) >> 16; }
__device__ __forceinline__ unsigned pk2(float lo, float hi) { return f2bf(lo) | (f2bf(hi) << 16); }
__device__ __forceinline__ float bflo(unsigned w) { return __uint_as_float(w << 16); }
__device__ __forceinline__ float bfhi(unsigned w) { return __uint_as_float(w & 0xffff0000u); }
__device__ __forceinline__ unsigned cvtpk(float lo, float hi) { unsigned r; asm volatile("v_cvt_pk_bf16_f32 %0, %1, %2" : "=v"(r) : "v"(lo), "v"(hi)); return r; }

namespace att {
constexpr int SHM_V = 64 * 128 * 2, SHM_K = 64 * 128 * 2;
constexpr int OFF_V = 0, OFF_K = 2 * SHM_V, OFF_SCR = 2 * SHM_V + 2 * SHM_K, OFF_FLAG = OFF_SCR + NWAVES * 64 * 4;
#define KSWZ(row, colB) ((row) * 256 + ((colB) ^ (((row) & 7) << 4)))
__device__ __forceinline__ int v_st(int k, int c) { const int kk = (k & ~0xC) | ((k & 4) << 1) | ((k & 8) >> 1); return ((kk >> 3) * 4 + (c >> 5)) * 512 + ((kk & 7) * 32 + (c & 31)) * 2; }
__device__ __forceinline__ int v_rd_base(int lane) { return ((lane & 3) << 3) | (((lane >> 2) & 3) << 6) | (((lane >> 4) & 1) << 5) | (((lane >> 5) & 1) << 8); }
constexpr int v_rd_off(int d0, int ks, int half) { return d0 * 512 + ks * 4096 + half * 2048; }
__device__ __forceinline__ int crow(int r, int hi) { return (r & 3) + 8 * (r >> 2) + 4 * hi; }

template <int KB>
__device__ __forceinline__ void qkt(f32x16& p0, f32x16& p1, LAS unsigned char* K_lds, int r32, int hi, const bf16x8* qr) {
    p0 = f32x16{}; p1 = f32x16{};
    const LAS unsigned char* kb[4];
#pragma unroll
    for (int dd = 0; dd < 4; ++dd) kb[dd] = K_lds + KB * SHM_K + KSWZ(r32, (dd * 16 + hi * 8) * 2);
#pragma unroll
    for (int d0 = 0; d0 < 8; ++d0) { const LAS unsigned char* a = kb[d0 & 3] + (d0 >> 2) * 128;
        bf16x8 b0 = *(const LAS bf16x8*)(a);
        bf16x8 b1 = *(const LAS bf16x8*)(a + 32 * 256);
        p0 = __builtin_amdgcn_mfma_f32_32x32x16_bf16(b0, qr[d0], p0, 0, 0, 0);
        p1 = __builtin_amdgcn_mfma_f32_32x32x16_bf16(b1, qr[d0], p1, 0, 0, 0); }
}
template <int VB>
__device__ __forceinline__ void pv_tile(f32x16* o, int vb0, bf16x8 pa0, bf16x8 pa1, bf16x8 pa2, bf16x8 pa3) {
#define TRRD(dst, off) asm volatile("ds_read_b64_tr_b16 %0, %1 offset:%2" : "=&v"(dst) : "v"(vb0), "i"(off) : "memory")
#define PV_D0(d0) do { s16x4 l0, l1, l2, l3, h0, h1, h2, h3; constexpr int b_ = VB * SHM_V + v_rd_off(d0, 0, 0); \
        TRRD(l0, b_); TRRD(h0, b_ + 2048); TRRD(l1, b_ + 4096); TRRD(h1, b_ + 6144); TRRD(l2, b_ + 8192); TRRD(h2, b_ + 10240); TRRD(l3, b_ + 12288); TRRD(h3, b_ + 14336); \
        LDS_WAIT(); SBAR(); \
        o[d0] = __builtin_amdgcn_mfma_f32_32x32x16_bf16(pa0, (bf16x8){l0[0], l0[1], l0[2], l0[3], h0[0], h0[1], h0[2], h0[3]}, o[d0], 0, 0, 0);   \
        o[d0] = __builtin_amdgcn_mfma_f32_32x32x16_bf16(pa1, (bf16x8){l1[0], l1[1], l1[2], l1[3], h1[0], h1[1], h1[2], h1[3]}, o[d0], 0, 0, 0);   \
        o[d0] = __builtin_amdgcn_mfma_f32_32x32x16_bf16(pa2, (bf16x8){l2[0], l2[1], l2[2], l2[3], h2[0], h2[1], h2[2], h2[3]}, o[d0], 0, 0, 0);   \
        o[d0] = __builtin_amdgcn_mfma_f32_32x32x16_bf16(pa3, (bf16x8){l3[0], l3[1], l3[2], l3[3], h3[0], h3[1], h3[2], h3[3]}, o[d0], 0, 0, 0); } while (0)
    PV_D0(0); PV_D0(1); PV_D0(2); PV_D0(3);
#undef PV_D0
#undef TRRD
}
__device__ __forceinline__ void pack_p(const f32x16& p0, const f32x16& p1, bf16x8& pa0, bf16x8& pa1, bf16x8& pa2, bf16x8& pa3) {
#define PK4(P, B_, OUT) do { unsigned a0 = cvtpk(P[B_+0], P[B_+1]), a1 = cvtpk(P[B_+2], P[B_+3]);                          \
        unsigned b0 = cvtpk(P[B_+4], P[B_+5]), b1 = cvtpk(P[B_+6], P[B_+7]);                                             \
        auto r0 = __builtin_amdgcn_permlane32_swap(a0, b0, false, false); auto r1 = __builtin_amdgcn_permlane32_swap(a1, b1, false, false); \
        v4u w = {r0[0], r1[0], r0[1], r1[1]}; OUT = __builtin_bit_cast(bf16x8, w); } while (0)
    PK4(p0, 0, pa0); PK4(p0, 8, pa1); PK4(p1, 0, pa2); PK4(p1, 8, pa3);
#undef PK4
}
__device__ __forceinline__ float xhalf_max(float v) { auto rr = __builtin_amdgcn_permlane32_swap(__float_as_uint(v), __float_as_uint(v), false, false); return fmaxf(__uint_as_float(rr[0]), __uint_as_float(rr[1])); }
__device__ __forceinline__ float xhalf_sum(float v) { auto rr = __builtin_amdgcn_permlane32_swap(__float_as_uint(v), __float_as_uint(v), false, false); return __uint_as_float(rr[0]) + __uint_as_float(rr[1]); }
__device__ __forceinline__ float xhalf_other(float v, int hi) { auto rr = __builtin_amdgcn_permlane32_swap(__float_as_uint(v), __float_as_uint(v), false, false); return __uint_as_float(hi ? rr[0] : rr[1]); }

struct St {
    f32x16 o[4]; float m_reg, l_reg, Lrun;
};

template <int MODE, int KB>
__device__ __forceinline__ void tile_step(St& S, LAS unsigned char* lds, int vb0, const bf16x8* qr, int r32, int hi, int wid, unsigned long long mw, int kt, int trow, bool act) {
    if (!act) return;
    f32x16 p0, p1;
    qkt<KB>(p0, p1, lds + OFF_K, r32, hi, qr);
    LAS float* scr = (LAS float*)(lds + OFF_SCR) + wid * 64; LAS float* al_l = scr + 32;
    bf16x8 pa0, pa1, pa2, pa3;
    if (MODE == 0) {
        constexpr float C2 = 1.4426950408889634f * 0.08838834764831845f;
        const float NEG = -__builtin_inff();
        const unsigned mlo = (unsigned)mw, mhi = (unsigned)(mw >> 32);
#pragma unroll
        for (int r = 0; r < 16; ++r) { const int c = (r & 3) + 8 * (r >> 2) + 4 * hi;
            if (!((mlo >> c) & 1u)) p0[r] = NEG;
            if (!((mhi >> c) & 1u)) p1[r] = NEG; }
        float pmax = p0[0];
#pragma unroll
        for (int r = 1; r < 16; ++r) pmax = fmaxf(pmax, p0[r]);
#pragma unroll
        for (int r = 0; r < 16; ++r) pmax = fmaxf(pmax, p1[r]);
        pmax = xhalf_max(pmax);
        const float mn = fmaxf(S.m_reg, pmax);
        const float alpha = __builtin_amdgcn_exp2f((S.m_reg - mn) * C2);
        S.m_reg = mn;
        const float mnL = -mn * C2;
        float ps = 0.f;
#pragma unroll
        for (int r = 0; r < 16; ++r) { p0[r] = __builtin_amdgcn_exp2f(fmaf(p0[r], C2, mnL)); p1[r] = __builtin_amdgcn_exp2f(fmaf(p1[r], C2, mnL)); ps += p0[r] + p1[r]; }
        ps = xhalf_sum(ps);
        S.l_reg = S.l_reg * alpha + ps;
        if (__any(alpha < 1.f)) {
            if (hi == 0) al_l[r32] = alpha;
            LDS_WAIT();
#pragma unroll
            for (int r = 0; r < 16; ++r) { const float a = al_l[crow(r, hi)];
#pragma unroll
                for (int d = 0; d < 4; ++d) S.o[d][r] *= a; }
        }
        pack_p(p0, p1, pa0, pa1, pa2, pa3);
    } else {
        constexpr float C2 = 1.4426950408889634f * 0.08838834764831845f;
        const int kbase = kt * 64 + 4 * hi;
        const bool needmask = (kt * 64 + 63 >= trow - r32);
        float lk0[16], lk1[16];
#pragma unroll
        for (int r = 0; r < 16; ++r) {
            const int key0 = kbase + (r & 3) + 8 * (r >> 2);
            { const float z2 = p0[r] * C2; const float sp = fmaxf(z2, 0.f) + __builtin_amdgcn_logf(1.0f + __builtin_amdgcn_exp2f(-fabsf(z2)));
              const bool msk = needmask && (key0 >= trow); lk0[r] = msk ? 0.f : -sp; p0[r] = msk ? -__builtin_inff() : (z2 - sp); }
            { const float z2 = p1[r] * C2; const float sp = fmaxf(z2, 0.f) + __builtin_amdgcn_logf(1.0f + __builtin_amdgcn_exp2f(-fabsf(z2)));
              const bool msk = needmask && (key0 + 32 >= trow); lk1[r] = msk ? 0.f : -sp; p1[r] = msk ? -__builtin_inff() : (z2 - sp); }
        }
        float So[8], Sp[8], W[8];
#pragma unroll
        for (int g = 0; g < 4; ++g) { So[g] = (lk0[4 * g] + lk0[4 * g + 1]) + (lk0[4 * g + 2] + lk0[4 * g + 3]); So[4 + g] = (lk1[4 * g] + lk1[4 * g + 1]) + (lk1[4 * g + 2] + lk1[4 * g + 3]); }
#pragma unroll
        for (int g = 0; g < 8; ++g) Sp[g] = xhalf_other(So[g], hi);
        float run = S.Lrun;
#pragma unroll
        for (int g = 7; g >= 0; --g) { W[g] = run + (hi == 0 ? Sp[g] : 0.f); run += So[g] + Sp[g]; }
        S.Lrun = run;
#pragma unroll
        for (int g = 0; g < 4; ++g) {
            { float e = W[g];     p0[4 * g + 3] = __builtin_amdgcn_exp2f(p0[4 * g + 3] + e); e += lk0[4 * g + 3]; p0[4 * g + 2] = __builtin_amdgcn_exp2f(p0[4 * g + 2] + e); e += lk0[4 * g + 2];
                                  p0[4 * g + 1] = __builtin_amdgcn_exp2f(p0[4 * g + 1] + e); e += lk0[4 * g + 1]; p0[4 * g]     = __builtin_amdgcn_exp2f(p0[4 * g] + e); }
            { float e = W[4 + g]; p1[4 * g + 3] = __builtin_amdgcn_exp2f(p1[4 * g + 3] + e); e += lk1[4 * g + 3]; p1[4 * g + 2] = __builtin_amdgcn_exp2f(p1[4 * g + 2] + e); e += lk1[4 * g + 2];
                                  p1[4 * g + 1] = __builtin_amdgcn_exp2f(p1[4 * g + 1] + e); e += lk1[4 * g + 1]; p1[4 * g]     = __builtin_amdgcn_exp2f(p1[4 * g] + e); }
        }
        pack_p(p0, p1, pa0, pa1, pa2, pa3);
    }
    pv_tile<KB>(S.o, vb0, pa0, pa1, pa2, pa3);
}

template <int MODE>
__device__ __forceinline__ void attn_unit(LAS unsigned char* lds, const bf16* __restrict__ H, const unsigned long long* __restrict__ mask, unsigned char* __restrict__ O, float oinv, int b, int h, int qb) {
    const int tid = pg8::opqv(threadIdx.x), wid = __builtin_amdgcn_readfirstlane(tid >> 6), lane = tid & 63, r32 = lane & 31, hi = lane >> 5;
    const int cq = (MODE == 0 ? C_QA : C_QB) + h * HD, ck = (MODE == 0 ? C_KA : C_KB) + h * HD, cv = (MODE == 0 ? C_VA : C_VB) + h * HD;
    const int trow = qb * 256 + wid * 32 + r32;
    const size_t grow = (size_t)b * SEQ + trow;
    bf16x8 qr[8];
#pragma unroll
    for (int d0 = 0; d0 < 8; ++d0) qr[d0] = *(const bf16x8*)(H + grow * LDH + cq + d0 * 16 + hi * 8);
    const int NT = 4 * qb + 4;
    const int sr = tid >> 4, sc = (tid & 15) * 8;
    const int vst0 = v_st(sr, sc), vst1 = v_st(32 + sr, sc), kws = KSWZ(sr, sc * 2);
    LAS unsigned char* V_lds = lds + OFF_V; LAS unsigned char* K_lds = lds + OFF_K;
    const int vb0 = (int)(unsigned)(size_t)(V_lds) + v_rd_base(lane);
    volatile LAS unsigned* flags = (volatile LAS unsigned*)(lds + OFF_FLAG);
    const bf16* Kg = H + (size_t)b * SEQ * LDH + ck + sc; const bf16* Vg = H + (size_t)b * SEQ * LDH + cv + sc;
    St S;
#pragma unroll
    for (int d = 0; d < 4; ++d) S.o[d] = f32x16{};
    S.m_reg = -1e30f; S.l_reg = 0.f; S.Lrun = 0.f;
    bf16x8 st_k0, st_k1, st_v0, st_v1;
#define KT_OF(t) (MODE == 0 ? (t) : (NT - 1 - (t)))
#define SLOAD(t) do { const size_t k0_ = (size_t)KT_OF(t) * 64; st_k0 = *(const bf16x8*)(Kg + (k0_ + sr) * LDH); st_k1 = *(const bf16x8*)(Kg + (k0_ + 32 + sr) * LDH); \
                      st_v0 = *(const bf16x8*)(Vg + (k0_ + sr) * LDH); st_v1 = *(const bf16x8*)(Vg + (k0_ + 32 + sr) * LDH); } while (0)
#define SWRITE(bf) do { *(LAS bf16x8*)(K_lds + (bf) * SHM_K + kws) = st_k0; *(LAS bf16x8*)(K_lds + (bf) * SHM_K + kws + 32 * 256) = st_k1; \
                        *(LAS bf16x8*)(V_lds + (bf) * SHM_V + vst0) = st_v0; *(LAS bf16x8*)(V_lds + (bf) * SHM_V + vst1) = st_v1; } while (0)
    SLOAD(0); VM_WAIT(); SWRITE(0); LDS_WAIT(); __syncthreads();
    const int wave_chunk = 4 * qb + (wid >> 1);
    const int tfirst = qb * 256 + wid * 32;
    int t = 0; unsigned long long mwn = 0ull; if (MODE == 0) mwn = mask[grow * 64];
#define STEP(KB, SB) do { \
        const int kt = KT_OF(t); \
        if (t + 1 < NT) SLOAD(t + 1); \
        bool act; unsigned long long mw = mwn; \
        if (MODE == 0) { act = (kt <= wave_chunk); if (t + 1 < NT && t + 1 <= wave_chunk) mwn = mask[grow * 64 + t + 1]; } \
        else { act = (kt * 64 < tfirst + 31) && !__all(S.Lrun < -136.f); } \
        tile_step<MODE, KB>(S, lds, vb0, qr, r32, hi, wid, mw, kt, trow, act); \
        if (t + 1 < NT) { VM_WAIT(); SWRITE(SB); } \
        if (MODE == 1) { const bool dn = __all(S.Lrun < -136.f); if (lane == 0) flags[(t & 1) * 8 + wid] = dn ? 1u : 0u; } \
        LDS_WAIT(); __syncthreads(); \
        if (MODE == 1) { unsigned all = 1u; _Pragma("unroll") for (int w_ = 0; w_ < 8; ++w_) all &= flags[(t & 1) * 8 + w_]; if (all) { t = NT; } } \
        ++t; } while (0)
    for (;;) {
        STEP(0, 1); if (t >= NT) break;
        STEP(1, 0); if (t >= NT) break;
    }
#undef STEP
#undef SLOAD
#undef SWRITE
#undef KT_OF
    LAS float* scr = (LAS float*)(lds + OFF_SCR) + wid * 64;
    float rli[16];
    if (MODE == 0) {
        if (hi == 0) scr[r32] = S.l_reg;
        LDS_WAIT();
#pragma unroll
        for (int r = 0; r < 16; ++r) rli[r] = __builtin_amdgcn_rcpf(scr[crow(r, hi)]);
    }
    unsigned char* Ow = O + ((size_t)b * SEQ + qb * 256 + wid * 32) * 1024 + h * HD;
#pragma unroll
    for (int r = 0; r < 16; ++r) { const int orow = crow(r, hi);
#pragma unroll
        for (int d0 = 0; d0 < 4; ++d0) { const float v = (MODE == 0 ? S.o[d0][r] * rli[r] : S.o[d0][r]) * oinv;
            int q = __float2int_rn(fminf(fmaxf(v, -127.f), 127.f)) & 0xff;
            const int q1 = __builtin_amdgcn_update_dpp(0, q, 0x55, 0xF, 0xF, true), q2 = __builtin_amdgcn_update_dpp(0, q, 0xAA, 0xF, 0xF, true), q3 = __builtin_amdgcn_update_dpp(0, q, 0xFF, 0xF, 0xF, true);
            if ((r32 & 3) == 0) *(unsigned*)(Ow + (size_t)orow * 1024 + d0 * 32 + r32) = (unsigned)q | ((unsigned)q1 << 8) | ((unsigned)q2 << 16) | ((unsigned)q3 << 24); } }
    LDS_WAIT(); __syncthreads();
}
__device__ __forceinline__ void sm_tile(St& S, f32x16& p0, f32x16& p1, unsigned long long mw, LAS float* al_l, int r32, int hi, bf16x8& pa0, bf16x8& pa1, bf16x8& pa2, bf16x8& pa3) {
    constexpr float C2 = 1.4426950408889634f * 0.08838834764831845f;
    const float NEG = -__builtin_inff();
    const unsigned mlo = (unsigned)mw, mhi = (unsigned)(mw >> 32);
#pragma unroll
    for (int r = 0; r < 16; ++r) { const int c = (r & 3) + 8 * (r >> 2) + 4 * hi;
        if (!((mlo >> c) & 1u)) p0[r] = NEG;
        if (!((mhi >> c) & 1u)) p1[r] = NEG; }
    float pmax = p0[0];
#pragma unroll
    for (int r = 1; r < 16; ++r) pmax = fmaxf(pmax, p0[r]);
#pragma unroll
    for (int r = 0; r < 16; ++r) pmax = fmaxf(pmax, p1[r]);
    pmax = xhalf_max(pmax);
    const float mn = fmaxf(S.m_reg, pmax);
    const float alpha = __builtin_amdgcn_exp2f((S.m_reg - mn) * C2);
    S.m_reg = mn;
    const float mnL = -mn * C2;
    float ps = 0.f;
#pragma unroll
    for (int r = 0; r < 16; ++r) { p0[r] = __builtin_amdgcn_exp2f(fmaf(p0[r], C2, mnL)); p1[r] = __builtin_amdgcn_exp2f(fmaf(p1[r], C2, mnL)); ps += p0[r] + p1[r]; }
    ps = xhalf_sum(ps);
    S.l_reg = S.l_reg * alpha + ps;
    if (__any(alpha < 1.f)) {
        if (hi == 0) al_l[r32] = alpha;
        LDS_WAIT();
#pragma unroll
        for (int r = 0; r < 16; ++r) { const float a = al_l[crow(r, hi)];
#pragma unroll
            for (int d = 0; d < 4; ++d) S.o[d][r] *= a; }
    }
    pack_p(p0, p1, pa0, pa1, pa2, pa3);
}
constexpr float SP_SCALE = 0.08838834764831845f, SP_THR = 8.f;
__device__ __forceinline__ void sp_partialSM(f32x16& p0, f32x16& p1, float& m_reg, float& mn, float& alpha) {
    float pmax = p0[0];
#pragma unroll
    for (int r = 1; r < 16; ++r) pmax = fmaxf(pmax, p0[r]);
#pragma unroll
    for (int r = 0; r < 16; ++r) pmax = fmaxf(pmax, p1[r]);
    pmax = xhalf_max(pmax);
    constexpr float C2 = 1.4426950408889634f * SP_SCALE;
    if (__builtin_expect(__all((pmax - m_reg) * SP_SCALE <= SP_THR), 1)) { mn = m_reg; alpha = 1.f; }
    else { mn = fmaxf(m_reg, pmax); alpha = __builtin_amdgcn_exp2f((m_reg - mn) * C2); m_reg = mn; }
    const float mnL = -mn * C2;
#pragma unroll
    for (int r = 0; r < 16; ++r) { p0[r] = fmaf(p0[r], C2, mnL); p1[r] = fmaf(p1[r], C2, mnL); }
#pragma unroll
    for (int r = 0; r < 16; ++r) p0[r] = __builtin_amdgcn_exp2f(p0[r]);
}
__device__ __forceinline__ void sp_finishSM(f32x16& p0, f32x16& p1, float alpha, float& l_reg, bf16x8& pa0, bf16x8& pa1, bf16x8& pa2, bf16x8& pa3) {
#pragma unroll
    for (int r = 0; r < 16; ++r) p1[r] = __builtin_amdgcn_exp2f(p1[r]);
    float ps = 0.f;
#pragma unroll
    for (int r = 0; r < 16; ++r) ps += p0[r];
#pragma unroll
    for (int r = 0; r < 16; ++r) ps += p1[r];
    ps = xhalf_sum(ps);
    l_reg = l_reg * alpha + ps;
    pack_p(p0, p1, pa0, pa1, pa2, pa3);
}
__device__ __forceinline__ void sp_mask(f32x16& p0, f32x16& p1, unsigned long long mw, int hi) {
    const float NEG = -__builtin_inff();
    const unsigned mlo = (unsigned)mw >> (4 * hi), mhi = (unsigned)(mw >> 32) >> (4 * hi);
#pragma unroll
    for (int r = 0; r < 16; ++r) { const unsigned bit = 1u << ((r & 3) + 8 * (r >> 2));
        if (!(mlo & bit)) p0[r] = NEG;
        if (!(mhi & bit)) p1[r] = NEG; }
}
__device__ __forceinline__ void sparse_unit_p(LAS unsigned char* lds, const bf16* __restrict__ H, const unsigned long long* __restrict__ mask, unsigned char* __restrict__ O, float oinv, int b, int h, int qb) {
    const int tid = pg8::opqv(threadIdx.x), wid = __builtin_amdgcn_readfirstlane(tid >> 6), lane = tid & 63, r32 = lane & 31, hi = lane >> 5;
    const int cq = C_QA + h * HD, ck = C_KA + h * HD, cv = C_VA + h * HD;
    const int trow = qb * 256 + wid * 32 + r32;
    const size_t grow = (size_t)b * SEQ + trow;
    bf16x8 qr[8];
#pragma unroll
    for (int d0 = 0; d0 < 8; ++d0) qr[d0] = *(const bf16x8*)(H + grow * LDH + cq + d0 * 16 + hi * 8);
    const int NT = 4 * qb + 4;
    const int sr = tid >> 4, sc = (tid & 15) * 8;
    const int vst0 = v_st(sr, sc), vst1 = v_st(32 + sr, sc), kws = KSWZ(sr, sc * 2);
    LAS unsigned char* V_lds = lds + OFF_V; LAS unsigned char* K_lds = lds + OFF_K;
    const int vb0 = (int)(unsigned)(size_t)(V_lds) + v_rd_base(lane);
    LAS float* scr = (LAS float*)(lds + OFF_SCR) + wid * 64; LAS float* li_l = scr; LAS float* al_l = scr + 32;
    const bf16* Kg = H + (size_t)b * SEQ * LDH + ck + sc; const bf16* Vg = H + (size_t)b * SEQ * LDH + cv + sc;
    const unsigned long long* mrow = mask + grow * 64;
    float m_reg = -1e30f, l_reg = 0.f; f32x16 o[4];
#pragma unroll
    for (int d = 0; d < 4; ++d) o[d] = f32x16{};
    bf16x8 st_k0, st_k1, st_v0, st_v1;
#define SLOADP(t) do { const size_t k0_ = (size_t)(t) * 64; st_v0 = *(const bf16x8*)(Vg + (k0_ + sr) * LDH); st_v1 = *(const bf16x8*)(Vg + (k0_ + 32 + sr) * LDH); \
                       st_k0 = *(const bf16x8*)(Kg + (k0_ + sr) * LDH); st_k1 = *(const bf16x8*)(Kg + (k0_ + 32 + sr) * LDH); } while (0)
#define SWRITEP(bf) do { *(LAS bf16x8*)(V_lds + (bf) * SHM_V + vst0) = st_v0; *(LAS bf16x8*)(V_lds + (bf) * SHM_V + vst1) = st_v1; \
                         *(LAS bf16x8*)(K_lds + (bf) * SHM_K + kws) = st_k0; *(LAS bf16x8*)(K_lds + (bf) * SHM_K + kws + 32 * 256) = st_k1; } while (0)
#define RESCP(a) do { if (__any((a) < 1.f)) { if (hi == 0) al_l[r32] = (a); LDS_WAIT(); \
        _Pragma("unroll") for (int d_ = 0; d_ < 4; ++d_) _Pragma("unroll") for (int r = 0; r < 16; ++r) o[d_][r] *= al_l[crow(r, hi)]; } } while (0)
    f32x16 pA0, pA1, pB0, pB1; float mnA, mnB, alA, alB; bf16x8 pa0, pa1, pa2, pa3;
    SLOADP(0); VM_WAIT(); SWRITEP(0); LDS_WAIT(); __syncthreads();
    SLOADP(1);
    unsigned long long mw = mrow[0];
    SBAR(); qkt<0>(pA0, pA1, K_lds, r32, hi, qr);
    sp_mask(pA0, pA1, mw, hi); sp_partialSM(pA0, pA1, m_reg, mnA, alA);
    VM_WAIT(); SWRITEP(1);
    LDS_WAIT(); __syncthreads();
    RESCP(alA);
#define HALF_STEPP(PX0, PX1, mnX, alX, PY0, PY1, alY, t, KB, VB, SB) do { \
        mw = mrow[(t)]; \
        SBAR(); qkt<KB>(PX0, PX1, K_lds, r32, hi, qr); \
        sp_finishSM(PY0, PY1, alY, l_reg, pa0, pa1, pa2, pa3); SBAR(); \
        if ((t) + 1 < NT) { SLOADP((t) + 1); SBAR(); } \
        pv_tile<VB>(o, vb0, pa0, pa1, pa2, pa3); sp_mask(PX0, PX1, mw, hi); sp_partialSM(PX0, PX1, m_reg, mnX, alX); \
        __syncthreads(); \
        if ((t) + 1 < NT) { VM_WAIT(); SWRITEP(SB); } \
        RESCP(alX); LDS_WAIT(); __syncthreads(); } while (0)
    for (int t = 1; t + 1 < NT; t += 2) {
        HALF_STEPP(pB0, pB1, mnB, alB, pA0, pA1, alA, t, 1, 0, 0);
        HALF_STEPP(pA0, pA1, mnA, alA, pB0, pB1, alB, t + 1, 0, 1, 1);
    }
    mw = mrow[NT - 1];
    SBAR(); qkt<1>(pB0, pB1, K_lds, r32, hi, qr); SBAR();
    sp_finishSM(pA0, pA1, alA, l_reg, pa0, pa1, pa2, pa3); SBAR();
    pv_tile<0>(o, vb0, pa0, pa1, pa2, pa3);
    sp_mask(pB0, pB1, mw, hi); sp_partialSM(pB0, pB1, m_reg, mnB, alB);
    RESCP(alB);
    sp_finishSM(pB0, pB1, alB, l_reg, pa0, pa1, pa2, pa3); SBAR();
    pv_tile<1>(o, vb0, pa0, pa1, pa2, pa3);
#undef HALF_STEPP
#undef RESCP
#undef SLOADP
#undef SWRITEP
    float rli[16];
    if (hi == 0) li_l[r32] = l_reg;
    LDS_WAIT();
#pragma unroll
    for (int r = 0; r < 16; ++r) rli[r] = __builtin_amdgcn_rcpf(li_l[crow(r, hi)]);
    unsigned char* Ow = O + ((size_t)b * SEQ + qb * 256 + wid * 32) * 1024 + h * HD;
#pragma unroll
    for (int r = 0; r < 16; ++r) { const int orow = crow(r, hi);
#pragma unroll
        for (int d0 = 0; d0 < 4; ++d0) { const float v = o[d0][r] * rli[r] * oinv;
            int q = __float2int_rn(fminf(fmaxf(v, -127.f), 127.f)) & 0xff;
            const int q1 = __builtin_amdgcn_update_dpp(0, q, 0x55, 0xF, 0xF, true), q2 = __builtin_amdgcn_update_dpp(0, q, 0xAA, 0xF, 0xF, true), q3 = __builtin_amdgcn_update_dpp(0, q, 0xFF, 0xF, 0xF, true);
            if ((r32 & 3) == 0) *(unsigned*)(Ow + (size_t)orow * 1024 + d0 * 32 + r32) = (unsigned)q | ((unsigned)q1 << 8) | ((unsigned)q2 << 16) | ((unsigned)q3 << 24); } }
    LDS_WAIT(); __syncthreads();
}
#undef KSWZ
}

__device__ __forceinline__ size_t sc_base(int b, int c) { return (size_t)b * (2048u * 64u * 65u) + (size_t)2048u * c * (c + 1); }
__device__ __forceinline__ void score_task(LAS unsigned char* lds, const bf16* __restrict__ H, float* __restrict__ SC, int b, int c, int h2, int wave, int tid_) {
    const int tid = pg8::opqv(tid_), lane = tid & 63;
    const int r32 = lane & 31, hi = lane >> 5;
    const int ql0 = 32 * h2 + 4 * wave, nk = 64 * (c + 1);
    bf16x8 A[2][4]; float w[2][16]; float* srow[2];
#pragma unroll
    for (int rb = 0; rb < 2; ++rb) {
        const int m = r32, q = (m >> 2) & 1, hh = (m & 3) + 4 * (m >> 3);
        const bf16* qp = H + ((size_t)b * SEQ + CHUNK * c + ql0 + 2 * rb + q) * LDH + C_QI + hh * IDXD + hi * 8;
#pragma unroll
        for (int ks = 0; ks < 4; ++ks) A[rb][ks] = *(const bf16x8*)(qp + ks * 16);
        const bf16* wp = H + ((size_t)b * SEQ + CHUNK * c + ql0 + 2 * rb + hi) * LDH + C_WI;
        const v4u w0 = *(const v4u*)wp, w1 = *(const v4u*)(wp + 8);
        w[rb][0] = bflo(w0.x); w[rb][1] = bfhi(w0.x); w[rb][2] = bflo(w0.y); w[rb][3] = bfhi(w0.y); w[rb][4] = bflo(w0.z); w[rb][5] = bfhi(w0.z); w[rb][6] = bflo(w0.w); w[rb][7] = bfhi(w0.w);
        w[rb][8] = bflo(w1.x); w[rb][9] = bfhi(w1.x); w[rb][10] = bflo(w1.y); w[rb][11] = bfhi(w1.y); w[rb][12] = bflo(w1.z); w[rb][13] = bfhi(w1.z); w[rb][14] = bflo(w1.w); w[rb][15] = bfhi(w1.w);
#pragma unroll
        for (int r = 0; r < 16; ++r) w[rb][r] *= 0.5f;
        srow[rb] = SC + sc_base(b, c) + (size_t)(ql0 + 2 * rb + hi) * nk + r32;
    }
    const int srw = tid >> 3, sc16 = tid & 7;
    const bf16* kg = H + ((size_t)b * SEQ + srw) * LDH + C_KI + sc16 * 8;
    const int wofs = srw * 128 + ((sc16 ^ (srw & 7)) << 4);
    int rofs[4];
#pragma unroll
    for (int ks = 0; ks < 4; ++ks) rofs[ks] = r32 * 128 + (((2 * ks + hi) ^ (r32 & 7)) << 4);
    bf16x8 st = *(const bf16x8*)kg;
    *(LAS bf16x8*)(lds + wofs) = st;
    VM_WAIT();
    LDS_WAIT(); __syncthreads();
#define SC_STEP(KC, BUF, STW, STL) do { \
        LAS unsigned char* cur = lds + (BUF) * 8192; \
        if ((KC) + 2 <= c) STL = *(const bf16x8*)(kg + (size_t)((KC) + 2) * 64 * LDH); \
        _Pragma("unroll") for (int h = 0; h < 2; ++h) { \
            bf16x8 Bf[4]; \
            _Pragma("unroll") for (int ks = 0; ks < 4; ++ks) Bf[ks] = *(const LAS bf16x8*)(cur + h * 4096 + rofs[ks]); \
            _Pragma("unroll") for (int rb = 0; rb < 2; ++rb) { \
                f32x16 acc = f32x16{}; \
                _Pragma("unroll") for (int ks = 0; ks < 4; ++ks) acc = __builtin_amdgcn_mfma_f32_32x32x16_bf16(A[rb][ks], Bf[ks], acc, 0, 0, 0); \
                f32x2v s2 = f32x2v{0.f, 0.f};                                     \
                _Pragma("unroll") for (int r = 0; r < 16; r += 2) { float t0 = acc[r] + __builtin_fabsf(acc[r]), t1 = acc[r + 1] + __builtin_fabsf(acc[r + 1]); asm("" : "+v"(t0), "+v"(t1)); const f32x2v t = f32x2v{t0, t1};     \
                    s2 = __builtin_elementwise_fma(f32x2v{w[rb][r], w[rb][r + 1]}, t, s2); } \
                srow[rb][64 * (KC) + 32 * h] = s2.x + s2.y; } } \
        if ((KC) + 1 <= c) *(LAS bf16x8*)(lds + (1 - (BUF)) * 8192 + wofs) = STW; \
        LDS_WAIT(); __syncthreads(); } while (0)
    bf16x8 stA = st, stB = st;
    if (c >= 1) stA = *(const bf16x8*)(kg + (size_t)64 * LDH);
    for (int kc = 0; kc <= c; kc += 2) {
        SC_STEP(kc, 0, stA, stB);
        if (kc + 1 <= c) SC_STEP(kc + 1, 1, stB, stA);
    }
#undef SC_STEP
}
__device__ __forceinline__ void select_task(const float* __restrict__ SC, unsigned* __restrict__ maskw, int b, int c, int p, int lane_) {
    const int lane = pg8::opqv(lane_);
    const int r32 = lane & 31, hi = lane >> 5;
    const int t0 = CHUNK * c + 2 * p, nkb = 2 * (c + 1), nk = 64 * (c + 1);
    const float* sp = SC + sc_base(b, c) + (size_t)(2 * p + hi) * nk + r32;
    unsigned su[128];
#pragma unroll
    for (int j = 0; j < 128; ++j) su[j] = 0u;
#pragma unroll
    for (int g = 0; g < 8; ++g) { if (g * 16 < nkb) {
#pragma unroll
        for (int jj = 0; jj < 16; ++jj) { const int j = g * 16 + jj; if (j < nkb) { unsigned u = __float_as_uint(sp[32 * j]); u ^= (u >> 31) ? 0xffffffffu : 0x80000000u; su[j] = u; } } } }
    unsigned T = 1u;
    if (nkb * 32 > TOPK) {
        unsigned prefix = 0u; bool fin = false;
        for (int bit = 31; bit >= 0; --bit) {
            const unsigned cand = prefix | (1u << bit);
            int c0 = 0, c1 = 0, c2 = 0, c3 = 0;
#pragma unroll
            for (int g = 0; g < 8; ++g) { if (g * 16 < nkb) {
#pragma unroll
                for (int j = 0; j < 16; j += 4) { unsigned long long m0, m1, m2, m3;
                    asm volatile("v_cmp_ge_u32_e64 %[m0], %[a0], %[cd]\n\tv_cmp_ge_u32_e64 %[m1], %[a1], %[cd]\n\tv_cmp_ge_u32_e64 %[m2], %[a2], %[cd]\n\tv_cmp_ge_u32_e64 %[m3], %[a3], %[cd]\n\t"
                                 "v_addc_co_u32_e64 %[c0], %[m0], 0, %[c0], %[m0]\n\tv_addc_co_u32_e64 %[c1], %[m1], 0, %[c1], %[m1]\n\tv_addc_co_u32_e64 %[c2], %[m2], 0, %[c2], %[m2]\n\tv_addc_co_u32_e64 %[c3], %[m3], 0, %[c3], %[m3]"
                                 : [c0] "+v"(c0), [c1] "+v"(c1), [c2] "+v"(c2), [c3] "+v"(c3), [m0] "=&s"(m0), [m1] "=&s"(m1), [m2] "=&s"(m2), [m3] "=&s"(m3)
                                 : [a0] "v"(su[g * 16 + j]), [a1] "v"(su[g * 16 + j + 1]), [a2] "v"(su[g * 16 + j + 2]), [a3] "v"(su[g * 16 + j + 3]), [cd] "v"(cand)); } } }
            int cnt = (c0 + c1) + (c2 + c3);
            cnt += __builtin_amdgcn_update_dpp(0, cnt, 0xB1, 0xF, 0xF, true);
            cnt += __builtin_amdgcn_update_dpp(0, cnt, 0x4E, 0xF, 0xF, true);
            cnt += __builtin_amdgcn_update_dpp(0, cnt, 0x141, 0xF, 0xF, true);
            cnt += __builtin_amdgcn_update_dpp(0, cnt, 0x140, 0xF, 0xF, true);
            cnt += __shfl_xor(cnt, 16);
            if (!fin && cnt >= TOPK) prefix = cand;
            fin = fin || (cnt == TOPK);
            if (__all(fin)) break;
        }
        T = prefix > 1u ? prefix : 1u;
    }
    unsigned wA0 = 0u, wB0 = 0u, wA1 = 0u, wB1 = 0u;
#pragma unroll
    for (int g = 0; g < 8; ++g) { if (g * 16 < nkb) {
#pragma unroll
        for (int jj = 0; jj < 16; ++jj) { const int j = g * 16 + jj;
        const unsigned long long bal = __ballot(su[j] >= T);
        const unsigned lo = (unsigned)bal, hi32 = (unsigned)(bal >> 32);
        if (j < 64) { wA0 = (lane == j) ? lo : wA0; wA1 = (lane == j) ? hi32 : wA1; }
        else { wB0 = (lane == j - 64) ? lo : wB0; wB1 = (lane == j - 64) ? hi32 : wB1; }
        } } }
    unsigned* mrow = maskw + ((size_t)b * SEQ + t0) * 128;
    mrow[lane] = wA0; mrow[64 + lane] = wB0; mrow[128 + lane] = wA1; mrow[192 + lane] = wB1;
}

__device__ __forceinline__ void kiwi_task(LAS unsigned char* lds, const unsigned char* __restrict__ XQ_, const unsigned char* __restrict__ WQ, const float* __restrict__ sx, const float* __restrict__ swm,
                                          const float* __restrict__ ropeI, bf16* __restrict__ H, int row0, int wave, int tid_) {
    typedef int v4i __attribute__((ext_vector_type(4)));
    const int tid = pg8::opqv(tid_), lane = tid & 63, l15 = lane & 15, q = lane >> 4;
    const int colA = 8 * (l15 >> 3) + 2 * ((l15 >> 2) & 1) + (l15 & 1) + 4 * ((l15 >> 1) & 1);
    LAS int* red = (LAS int*)lds;
    for (int i = tid; i < 20 * 256; i += NWAVES * 64) red[i] = 0;
    const unsigned char* bp = XQ_ + (size_t)(row0 + l15) * DM + wave * 256 + 16 * q;
    const unsigned char* ap = WQ + (size_t)colA * DM + wave * 256 + 16 * q;
    v4i acc[4][5];
#pragma unroll
    for (int rt = 0; rt < 4; ++rt)
#pragma unroll
        for (int ct = 0; ct < 5; ++ct) acc[rt][ct] = v4i{0, 0, 0, 0};
#pragma unroll 1
    for (int hb = 0; hb < 2; ++hb) {
        v4i bf[4][2], af[5][2];
#pragma unroll
        for (int rt = 0; rt < 4; ++rt)
#pragma unroll
            for (int ks = 0; ks < 2; ++ks) bf[rt][ks] = *(const v4i*)(bp + (size_t)rt * 16 * DM + ks * 64);
#pragma unroll
        for (int ct = 0; ct < 5; ++ct)
#pragma unroll
            for (int ks = 0; ks < 2; ++ks) af[ct][ks] = *(const v4i*)(ap + (size_t)ct * 16 * DM + ks * 64);
#pragma unroll
        for (int ks = 0; ks < 2; ++ks)
#pragma unroll
            for (int rt = 0; rt < 4; ++rt)
#pragma unroll
                for (int ct = 0; ct < 5; ++ct) acc[rt][ct] = __builtin_amdgcn_mfma_i32_16x16x64_i8(af[ct][ks], bf[rt][ks], acc[rt][ct], 0, 0, 0);
        bp += 128; ap += 128;
    }
    LDS_WAIT(); __syncthreads();
#pragma unroll
    for (int rt = 0; rt < 4; ++rt)
#pragma unroll
        for (int ct = 0; ct < 5; ++ct)
#pragma unroll
            for (int r = 0; r < 4; ++r) __hip_atomic_fetch_add(red + ((rt * 5 + ct) * 4 + r) * 64 + lane, acc[rt][ct][r], __ATOMIC_RELAXED, __HIP_MEMORY_SCOPE_WORKGROUP);
    LDS_WAIT(); __syncthreads();
    for (int t = wave; t < 20; t += NWAVES) {
        const int rt = t / 5, ct = t - 5 * rt, row = row0 + 16 * rt + l15;
        const float rs = sx[row];
        bf16* hrow = H + (size_t)row * LDH + C_KI;
        const int s0 = red[(t * 4 + 0) * 64 + lane], s1 = red[(t * 4 + 1) * 64 + lane], s2 = red[(t * 4 + 2) * 64 + lane], s3 = red[(t * 4 + 3) * 64 + lane];
        const int cb = 16 * ct + 8 * (q >> 1) + 2 * (q & 1);
        const float* sw = swm + C_KI + cb;
        float v0 = (float)s0 * (sw[0] * (1.0f / 127.0f)) * rs, v1 = (float)s1 * (sw[1] * (1.0f / 127.0f)) * rs;
        float v2 = (float)s2 * (sw[4] * (1.0f / 127.0f)) * rs, v3 = (float)s3 * (sw[5] * (1.0f / 127.0f)) * rs;
        if (ct < 4) {
            const f32x4 tb = *(const f32x4*)(ropeI + ((size_t)row * 32 + 4 * (2 * ct + (q >> 1)) + 2 * (q & 1)) * 2);
            const float y0 = v0 * tb[0] - v2 * tb[1], y2 = v2 * tb[0] + v0 * tb[1], y1 = v1 * tb[2] - v3 * tb[3], y3 = v3 * tb[2] + v1 * tb[3];
            v0 = y0; v1 = y1; v2 = y2; v3 = y3; }
        *(unsigned*)(hrow + cb) = cvtpk(v0, v1); *(unsigned*)(hrow + cb + 4) = cvtpk(v2, v3);
    }
    LDS_WAIT(); __syncthreads();
}
constexpr size_t MiB = 1u << 20;
constexpr size_t WS_CTL = 0, CTL_ZERO_BYTES = 2 * MiB;
constexpr int CW_TMO = 0, CW_BAR = 4096;
constexpr size_t WS_SWMAX = 512 * 1024;
constexpr int SWM_WIN = 0, SWM_FGU = 2 * LDH, SWM_MGU = SWM_FGU + 2 * DFF, SWM_PA = SWM_MGU + NEXP * 2 * DEXP, SWM_PB = SWM_PA + 2 * DM, SWM_VMAX = SWM_PB + 2 * DM  , SWM_END = SWM_VMAX + 4;
static_assert(WS_SWMAX + (size_t)SWM_END * 4 <= CTL_ZERO_BYTES, "absmax words inside the memset region");
constexpr size_t WS_WINQ = 2 * MiB;
constexpr size_t WS_PA = WS_WINQ + 2 * (size_t)LDH * DM;
constexpr size_t WS_PB = WS_PA + 2 * (size_t)DM * 1024;
constexpr size_t WS_WOUT = WS_PB + 2 * (size_t)DM * 1024;
constexpr size_t WS_FGUQ = WS_WOUT + 2 * (size_t)DM * DM * 2;
constexpr size_t WS_FD = WS_FGUQ + (size_t)2 * DFF * DM;
constexpr size_t WS_MGUQ = WS_FD + (size_t)DM * DFF * 2;
constexpr size_t WS_MD = WS_MGUQ + (size_t)NEXP * 2 * DEXP * DM;
constexpr size_t WS_XS = WS_MD + (size_t)NEXP * DM * DEXP * 2;
constexpr size_t WS_XQ = WS_XS + (size_t)MTOK * DM * 2;
constexpr size_t WS_SX = WS_XQ + (size_t)MTOK * DM;
constexpr size_t WS_STATS = WS_SX + (size_t)MTOK * 4;
constexpr size_t WS_ROPEH = WS_STATS + (size_t)MTOK * 8;
constexpr size_t WS_ROPEI = WS_ROPEH + (size_t)MTOK * 64 * 2 * 4;
constexpr size_t WS_TOK = WS_ROPEI + (size_t)MTOK * 32 * 2 * 4;
constexpr size_t WS_BCNT = WS_TOK + (size_t)MTOK * 16;
constexpr size_t WS_ARENA = (WS_BCNT + 256 * 8 * 4 + 64 + MiB - 1) / MiB * MiB;
constexpr size_t WS_H = WS_ARENA;
constexpr size_t WS_OA = WS_H + (size_t)MTOK * LDH * 2;
constexpr size_t WS_OB = WS_OA + (size_t)MTOK * 1024;
constexpr size_t WS_MG = WS_OB + (size_t)MTOK * 1024;
constexpr size_t WS_MASK = WS_MG + (size_t)MTOK * DM * 2;
constexpr size_t WS_SC = WS_MASK + (size_t)MTOK * 64 * 8;
constexpr size_t WS_MIX_END = WS_SC + (size_t)BATCH * 2048 * 64 * 65 * 4;
constexpr size_t WS_HD = WS_ARENA;
constexpr size_t WS_XGQ = WS_ARENA;
constexpr size_t WS_SO = WS_ARENA;
constexpr size_t WS_HDM = WS_SO + (size_t)MAXSLOT * DM * 2;
constexpr size_t WS_SXG = WS_HDM + (size_t)MAXSLOT * DEXP * 2;
constexpr size_t WS_PART = (WS_SXG + (size_t)MAXSLOT * 4 + 255) / 256 * 256;
constexpr size_t WS_FFN_END = WS_PART + (size_t)7 * 2048 * DM * 4;
constexpr size_t WS_END = WS_MIX_END > WS_FFN_END ? WS_MIX_END : WS_FFN_END;

constexpr int RING_OFF = 0, RING_BYTES = 131072;
constexpr int LDSCTL_OFF = RING_BYTES, MISC_OFF = LDSCTL_OFF + 320;
static_assert(MISC_OFF + 8192 == 139584, "gemm_phase PF_OFF");
constexpr int LDS_BYTES = 147456;

#define XB_TMO      128
#define XB_XCNT(j)  (256  + 64 * (j))
#define XB_XSUB(j)  (1280 + 64 * (j))
#define XB_XGEN(j)  (2304 + 64 * (j))
#define XB_TOP      3328
#define XB_TOPGEN   3392
#define XCD_BAR_WORDS 3456
#define XB_SPIN_CAP (1u << 20)
__device__ __forceinline__ unsigned xb_ld(unsigned* p)              { return __hip_atomic_load(p, __ATOMIC_RELAXED, __HIP_MEMORY_SCOPE_AGENT); }
__device__ __forceinline__ unsigned xb_add(unsigned* p, unsigned v) { return __hip_atomic_fetch_add(p, v, __ATOMIC_RELAXED, __HIP_MEMORY_SCOPE_AGENT); }
__device__ __forceinline__ unsigned xb_xcc_id() { return (unsigned)__builtin_amdgcn_s_getreg((3 << 11) | 20) & 0xFu; }
#define XB_SPIN(cond, bar) do { unsigned _sp = 0; while (cond) { __builtin_amdgcn_s_sleep(1); \
    if ((++_sp & 255u) == 0u) { if (xb_ld(&(bar)[XB_TMO])) break; if (_sp > XB_SPIN_CAP) { atomicAdd(&(bar)[XB_TMO], 1u); break; } } } } while (0)
struct XcdBarrier { unsigned* bar; unsigned x; volatile LAS unsigned* st; };
__device__ __forceinline__ XcdBarrier xcd_barrier_post(unsigned* bar, volatile LAS unsigned* st) {
    XcdBarrier b; b.bar = bar; b.x = xb_xcc_id(); b.st = st;
    if (threadIdx.x == 0) (void)xb_add(&bar[XB_XCNT(b.x)], 1u);
    return b;
}
__device__ __forceinline__ void xcd_barrier_complete(unsigned* bar, unsigned x, unsigned& nloc, unsigned& nx) {
    const unsigned G = gridDim.x * gridDim.y * gridDim.z;
    unsigned sum, cnt, mine, sp = 0u;
    for (;;) {
        sum = 0u; cnt = 0u; mine = 0u;
#pragma unroll
        for (unsigned j = 0; j < 16; ++j) { const unsigned c = xb_ld(&bar[XB_XCNT(j)]); sum += c; cnt += (c > 0u) ? 1u : 0u; mine = (j == x) ? c : mine; }
        if (sum == G) break;
        __builtin_amdgcn_s_sleep(1);
        if ((++sp & 255u) == 0u) { if (xb_ld(&bar[XB_TMO])) break; if (sp > XB_SPIN_CAP) { atomicAdd(&bar[XB_TMO], 1u); break; } }
    }
    nloc = mine > 0u ? mine : 1u; nx = cnt > 0u ? cnt : 1u;
}
__device__ __forceinline__ void xcd_barrier(const XcdBarrier& b) {
    asm volatile("s_waitcnt vmcnt(0)" ::: "memory");
    __syncthreads();
    if (threadIdx.x == 0) {
        unsigned* bar = b.bar;
        __builtin_amdgcn_s_waitcnt(0);
        unsigned nloc = b.st[0], nx = b.st[1];
        if (nloc == 0u) { xcd_barrier_complete(bar, b.x, nloc, nx); b.st[0] = nloc; b.st[1] = nx; }
        const unsigned old = xb_add(&bar[XB_XSUB(b.x)], 1u);
        const unsigned gen = old / nloc;
        if (old + 1u == (gen + 1u) * nloc) {
            __builtin_amdgcn_fence(__ATOMIC_RELEASE, "agent");
            asm volatile("s_waitcnt vmcnt(0)" ::: "memory");
            const unsigned og = xb_add(&bar[XB_TOP], 1u);
            const unsigned tg = og / nx;
            if (og + 1u == (tg + 1u) * nx) xb_add(&bar[XB_TOPGEN], 1u);
            else XB_SPIN(xb_ld(&bar[XB_TOPGEN]) == tg, bar);
            __builtin_amdgcn_fence(__ATOMIC_ACQUIRE, "agent");
            xb_add(&bar[XB_XGEN(b.x)], 1u);
            asm volatile("s_waitcnt vmcnt(0)" ::: "memory");
        } else {
            XB_SPIN(xb_ld(&bar[XB_XGEN(b.x)]) == gen, bar);
            __builtin_amdgcn_fence(__ATOMIC_ACQUIRE, "agent");
            asm volatile("s_waitcnt vmcnt(0)" ::: "memory");
        }
    }
    __syncthreads();
}

__device__ __forceinline__ float wave_sum(float v) {
#pragma unroll
    for (int o = 1; o < 64; o <<= 1) v += __shfl_xor(v, o);
    return v;
}
__device__ __forceinline__ unsigned xshf(unsigned x, int s) {
    if (s == 1) return (unsigned)__builtin_amdgcn_update_dpp(0, (int)x, 0xB1, 0xF, 0xF, true);
    if (s == 2) return (unsigned)__builtin_amdgcn_update_dpp(0, (int)x, 0x4E, 0xF, 0xF, true);
    const int t = __builtin_amdgcn_update_dpp(0, (int)x, 0x141, 0xF, 0xF, true);
    return (unsigned)__builtin_amdgcn_update_dpp(0, t, 0x1B, 0xF, 0xF, true);
}
__device__ __forceinline__ void tr8x8(v4u (&E)[8], int lane) {
#pragma unroll
    for (int s = 4; s >= 1; s >>= 1) {
        const bool up = (lane & s) != 0;
#pragma unroll
        for (int j = 0; j < 8; ++j) if ((j & s) == 0) {
            const v4u a = E[j], b = E[j | s]; v4u r;
            r.x = xshf(up ? a.x : b.x, s); r.y = xshf(up ? a.y : b.y, s); r.z = xshf(up ? a.z : b.z, s); r.w = xshf(up ? a.w : b.w, s);
            E[j].x = up ? r.x : a.x; E[j].y = up ? r.y : a.y; E[j].z = up ? r.z : a.z; E[j].w = up ? r.w : a.w;
            E[j | s].x = up ? b.x : r.x; E[j | s].y = up ? b.y : r.y; E[j | s].z = up ? b.z : r.z; E[j | s].w = up ? b.w : r.w;
        }
    }
}
__device__ __forceinline__ int dst_row(int type, int off, int n) {
    if (type == 0) return n + off;
    if (type == 1) return 256 * (n >> 7) + off + (n & 127);
    if (n < 2048) { const int d = n & 127, i = d & 63, hf = d >> 6; return (n & ~127) + 8 * (i >> 2) + (i & 3) + 4 * hf; }
    if (n < 3072) return n;
    if (n < 4096) { const int d = n & 63, i = d & 31, hf = d >> 5; return (n & ~63) + 8 * (i >> 2) + (i & 3) + 4 * hf; }
    if (n < 4160) { const int d = n - 4096, i = d & 31, hf = d >> 5; return C_KI + 8 * (i >> 2) + (i & 3) + 4 * hf; }
    if (n < 4176) return n + (C_KI - 4096);
    return n - 80;
}
__device__ __forceinline__ void tr_item(const float* __restrict__ W, int K, int N, bf16* __restrict__ WT, int type, int off, int item, int lane) {
    const int nblk = (N + 63) >> 6, kb = item / nblk, nb = item - kb * nblk, k0 = 64 * kb, n = 64 * nb + lane;
    const float* src = W + (size_t)k0 * N + n;
    float v[64];
#pragma unroll
    for (int k = 0; k < 64; ++k) { v[k] = __builtin_nontemporal_load(src); src += N; }
    v4u o[8];
#pragma unroll
    for (int j = 0; j < 8; ++j) { o[j].x = pk2(v[8 * j], v[8 * j + 1]); o[j].y = pk2(v[8 * j + 2], v[8 * j + 3]); o[j].z = pk2(v[8 * j + 4], v[8 * j + 5]); o[j].w = pk2(v[8 * j + 6], v[8 * j + 7]); }
    tr8x8(o, lane);
    const int il = lane & 7;
#pragma unroll
    for (int c = 0; c < 8; ++c) *(v4u*)(WT + (size_t)dst_row(type, off, n - il + c) * K + k0 + 8 * il) = o[c];
}
__device__ __forceinline__ unsigned pack4q(float a, float b, float c, float d, float inv) {
    const int q0 = __float2int_rn(a * inv), q1 = __float2int_rn(b * inv), q2 = __float2int_rn(c * inv), q3 = __float2int_rn(d * inv);
    return ((unsigned)q0 & 0xffu) | (((unsigned)q1 & 0xffu) << 8) | (((unsigned)q2 & 0xffu) << 16) | ((unsigned)q3 << 24);
}
__device__ __forceinline__ void amax_item(const float* __restrict__ W, int K, int N, unsigned* __restrict__ swmax, int type, int off, int item, int lane) {
    const int nblk = (N + 63) >> 6, kq = item / nblk, nb = item - kq * nblk, n = 64 * nb + lane, kr = K >> 2;
    if (n < N) {
        const float* src = W + (size_t)(kq * kr) * N + n; float am = 0.f;
        for (int kb = 0; kb < (kr >> 6); ++kb) {
            float v[64];
#pragma unroll
            for (int k = 0; k < 64; ++k) { v[k] = *src; src += N; }
#pragma unroll
            for (int k = 0; k < 64; ++k) am = fmaxf(am, fabsf(v[k]));
        }
        atomicMax(swmax + dst_row(type, off, n), __float_as_uint(am));
    }
}
__device__ __forceinline__ void quant_item(const float* __restrict__ W, int K, int N, unsigned char* __restrict__ WQ, const unsigned* __restrict__ swmax, int type, int off, int item, int lane) {
    const int nblk = (N + 63) >> 6, kb = item / nblk, nb = item - kb * nblk, k0 = 128 * kb, n = 64 * nb + lane;
    if (n < N) {
        const int dr = dst_row(type, off, n); const float am = __uint_as_float(swmax[dr]); const float inv = am > 0.f ? 127.0f / am : 0.f;
        const float* src = W + (size_t)k0 * N + n;
        float v[128];
#pragma unroll
        for (int k = 0; k < 128; ++k) { v[k] = __builtin_nontemporal_load(src); src += N; }
        unsigned char* dst = WQ + (size_t)dr * K + k0;
#pragma unroll
        for (int j = 0; j < 8; ++j) { v4u o; o.x = pack4q(v[16 * j], v[16 * j + 1], v[16 * j + 2], v[16 * j + 3], inv); o.y = pack4q(v[16 * j + 4], v[16 * j + 5], v[16 * j + 6], v[16 * j + 7], inv);
            o.z = pack4q(v[16 * j + 8], v[16 * j + 9], v[16 * j + 10], v[16 * j + 11], inv); o.w = pack4q(v[16 * j + 12], v[16 * j + 13], v[16 * j + 14], v[16 * j + 15], inv);
            *(v4u*)(dst + 16 * j) = o; }
    }
}
__device__ __forceinline__ void quant_tile(LAS unsigned* colmax, const float* __restrict__ W, int K, int N, unsigned char* __restrict__ WQ, unsigned* __restrict__ swmax, int type, int off, int tile, int tid) {
    const int nwl = (K == 2048) ? 5 : 6, nw = 1 << nwl;
    const int nl = tid & (nw - 1), kg = tid >> nwl, n = tile * nw + nl, k0 = kg * 128;
    const bool ok = n < N;
    if (tid < 64) colmax[tid] = 0u;
    float v[128]; float am = 0.f;
    if (ok) { const float* src = W + (size_t)k0 * N + n;
#pragma unroll
        for (int k = 0; k < 128; ++k) { v[k] = __builtin_nontemporal_load(src); src += N; }
#pragma unroll
        for (int k = 0; k < 128; ++k) am = fmaxf(am, fabsf(v[k])); }
    __syncthreads();
    if (ok) __hip_atomic_fetch_max(colmax + nl, __float_as_uint(am), __ATOMIC_RELAXED, __HIP_MEMORY_SCOPE_WORKGROUP);
    __syncthreads();
    v4u o[8];
    { const float cm = __uint_as_float(colmax[nl]); const float inv = (ok && cm > 0.f) ? 127.0f / cm : 0.f;
      if (ok && kg == 0) swmax[dst_row(type, off, n)] = __float_as_uint(cm);
#pragma unroll
      for (int j = 0; j < 8; ++j) { if (ok) { o[j].x = pack4q(v[16 * j], v[16 * j + 1], v[16 * j + 2], v[16 * j + 3], inv); o[j].y = pack4q(v[16 * j + 4], v[16 * j + 5], v[16 * j + 6], v[16 * j + 7], inv);
            o[j].z = pack4q(v[16 * j + 8], v[16 * j + 9], v[16 * j + 10], v[16 * j + 11], inv); o[j].w = pack4q(v[16 * j + 12], v[16 * j + 13], v[16 * j + 14], v[16 * j + 15], inv); }
          else o[j] = (v4u){0u, 0u, 0u, 0u}; } }
    tr8x8(o, tid);
    { const int il = tid & 7;
      if (ok) {
#pragma unroll
        for (int c = 0; c < 8; ++c) *(v4u*)(WQ + (size_t)dst_row(type, off, n - il + c) * K + k0 + 16 * il) = o[c]; } }
    __syncthreads();
}
struct Ptrs {
    const float* x; const int* pos; const float* ln_in_g; const float* ln_in_b; const float* w_in; const float* w_proj_a; const float* w_proj_b; const float* w_out;
    const float* ln_mix_g; const float* ln_mix_b; const float* ffn_w_gate; const float* ffn_w_up; const float* ffn_w_down; const float* router_w;
    const float* moe_w_gate; const float* moe_w_up; const float* moe_w_down; const float* ln_ffn_g; const float* ln_ffn_b;
    float* out; unsigned char* ws; int ph_lo, ph_hi, li, pad;
};
__device__ __forceinline__ void ln_regs(f32x4 (&v)[8], const float* __restrict__ g, const float* __restrict__ bta, int lane, float* stat = nullptr) {
    float s = 0.f;
#pragma unroll
    for (int j = 0; j < 8; ++j) s += (v[j].x + v[j].y) + (v[j].z + v[j].w);
    const float mean = wave_sum(s) * (1.f / DM); float s2 = 0.f;
#pragma unroll
    for (int j = 0; j < 8; ++j) { v[j] = v[j] - mean; s2 += (v[j].x * v[j].x + v[j].y * v[j].y) + (v[j].z * v[j].z + v[j].w * v[j].w); }
    const float rstd = 1.f / sqrtf(wave_sum(s2) * (1.f / DM) + LN_EPS);
    if (stat && lane == 0) { stat[0] = mean; stat[1] = rstd; }
#pragma unroll
    for (int j = 0; j < 8; ++j) { const f32x4 gg = *((const f32x4*)g + lane + 64 * j), bb = *((const f32x4*)bta + lane + 64 * j); v[j] = v[j] * rstd * gg + bb; }
}
__device__ __forceinline__ void ln_regs_r(f32x4 (&v)[8], const f32x4 (&gg)[8], const f32x4 (&bb)[8], int lane, float* stat = nullptr) {
    float s = 0.f;
#pragma unroll
    for (int j = 0; j < 8; ++j) s += (v[j].x + v[j].y) + (v[j].z + v[j].w);
    const float mean = wave_sum(s) * (1.f / DM); float s2 = 0.f;
#pragma unroll
    for (int j = 0; j < 8; ++j) { v[j] = v[j] - mean; s2 += (v[j].x * v[j].x + v[j].y * v[j].y) + (v[j].z * v[j].z + v[j].w * v[j].w); }
    const float rstd = 1.f / sqrtf(wave_sum(s2) * (1.f / DM) + LN_EPS);
    if (stat && lane == 0) { stat[0] = mean; stat[1] = rstd; }
#pragma unroll
    for (int j = 0; j < 8; ++j) v[j] = v[j] * rstd * gg[j] + bb[j];
}
__device__ __forceinline__ float wave_max(float v) {
#pragma unroll
    for (int o = 1; o < 64; o <<= 1) v = fmaxf(v, __shfl_xor(v, o));
    return v;
}
__device__ __forceinline__ void store_row(const f32x4 (&v)[8], float* xs_row, unsigned char* xq_row, float* sx, int lane) {
    if (xs_row) {
#pragma unroll
        for (int j = 0; j < 8; ++j) *((f32x4*)xs_row + lane + 64 * j) = v[j]; }
    if (xq_row) {
        float am = 0.f;
#pragma unroll
        for (int j = 0; j < 8; ++j) am = fmaxf(fmaxf(am, fmaxf(fabsf(v[j].x), fabsf(v[j].y))), fmaxf(fabsf(v[j].z), fabsf(v[j].w)));
        am = wave_max(am);
        const float inv = am > 0.f ? 127.0f / am : 0.f;
#pragma unroll
        for (int j = 0; j < 8; ++j) *((unsigned*)xq_row + lane + 64 * j) = pack4q(v[j].x, v[j].y, v[j].z, v[j].w, inv);
        if (lane == 0) *sx = am * (1.0f / 127.0f);
    }
}
#ifndef MK_ONE_LAUNCH
#define MK_ONE_LAUNCH 1
#endif
#ifndef MK_SKIP_MIXER
#define MK_SKIP_MIXER 0
#endif
#ifndef MK_PHASE_MASK
#define MK_PHASE_MASK 0xFFFF
#endif
#define PH_ON(k) (((MK_PHASE_MASK) >> (k)) & 1)
#ifndef MK_REP_MASK
#define MK_REP_MASK 0ull
#endif
#define REPN(p) ((((unsigned long long)(MK_REP_MASK)) >> (p)) & 1ull ? 2 : 1)
constexpr int PRO_NC = 1;
constexpr int PRO_PH = 1 + PRO_NC, PH_PER_LAYER = 11, N_PHASES = PRO_PH + 2 * PH_PER_LAYER;
__device__ __forceinline__ void pro_chunk(int c, int& a0, int& a0n, int& a1, int& a1n, int& q0, int& q0n, int& q1, int& q1n) {
    (void)c; a0 = 0; a0n = 9808; a1 = 0; a1n = 0; q0 = 0; q0n = 38208; q1 = 0; q1n = 0;
}

__device__ __forceinline__ void load_row(f32x4 (&v)[8], const bf16* row, int lane) {
#pragma unroll
    for (int j = 0; j < 8; ++j) { const v2u w = *((const v2u*)row + lane + 64 * j); v[j] = (f32x4){bflo(w.x), bfhi(w.x), bflo(w.y), bfhi(w.y)}; }
}
__device__ __forceinline__ void load_row(f32x4 (&v)[8], const float* row, int lane) {
#pragma unroll
    for (int j = 0; j < 8; ++j) v[j] = *((const f32x4*)row + lane + 64 * j);
}

template <class T> __device__ __forceinline__ T* opq(T* p) { asm volatile("" : "+s"(p)); return p; }
__device__ __forceinline__ int opqi(int v) { asm volatile("" : "+s"(v)); return v; }
using pg8::ldptr;
__global__ void __launch_bounds__(NWAVES * 64, 2) fwd_kernel(Ptrs a) {
    extern __shared__ __attribute__((aligned(16))) unsigned char lds_raw[];
    LAS unsigned char* lds = (LAS unsigned char*)lds_raw;
    volatile LAS unsigned* MISC = (volatile LAS unsigned*)(lds + MISC_OFF);
    const int tid0 = threadIdx.x, lane0 = tid0 & 63, wave = __builtin_amdgcn_readfirstlane(tid0 >> 6);
    const int G = gridDim.x, blk = blockIdx.x;
    const int gw = blk * NWAVES + wave, NGW = G * NWAVES;
    for (int u = tid0; u < (LDS_BYTES - LDSCTL_OFF) / 4; u += NWAVES * 64) ((LAS unsigned*)(lds + LDSCTL_OFF))[u] = 0u;
    __syncthreads();
    volatile LAS unsigned* PT = (volatile LAS unsigned*)(lds + MISC_OFF + 2048);
    if (tid0 == 0) {
#define PUTP(k, p) do { const unsigned long long v_ = (unsigned long long)(p); PT[2 * (k)] = (unsigned)v_; PT[2 * (k) + 1] = (unsigned)(v_ >> 32); } while (0)
        PUTP(0, a.x);         PUTP(1, a.pos);         PUTP(2, a.ln_in_g);         PUTP(3, a.ln_in_b);
        PUTP(4, a.w_in);         PUTP(5, a.w_proj_a);         PUTP(6, a.w_proj_b);         PUTP(7, a.w_out);
        PUTP(8, a.ln_mix_g);         PUTP(9, a.ln_mix_b);         PUTP(10, a.ffn_w_gate);         PUTP(11, a.ffn_w_up);
        PUTP(12, a.ffn_w_down);         PUTP(13, a.router_w);         PUTP(14, a.moe_w_gate);         PUTP(15, a.moe_w_up);
        PUTP(16, a.moe_w_down);         PUTP(17, a.ln_ffn_g);         PUTP(18, a.ln_ffn_b);         PUTP(19, a.out);
PUTP(20, a.ws); PUTP(21, a.ws + WS_XS); PUTP(22, a.ws + WS_STATS);
#undef PUTP
    }
    const int a_lo = a.ph_lo, a_hi = a.ph_hi, a_li = a.li;
    __syncthreads();
#define WINQ (ws + WS_WINQ)
#define PAQ (ws + WS_PA)
#define PBQ (ws + WS_PB)
#define WOUT_T ((bf16*)(ws + WS_WOUT))
#define FGUQ (ws + WS_FGUQ)
#define FD_T ((bf16*)(ws + WS_FD))
#define MGUQ (ws + WS_MGUQ)
#define MD_T ((bf16*)(ws + WS_MD))
#define XS ((bf16*)(ws + WS_XS))
#define XQ (ws + WS_XQ)
#define SX ((float*)(ws + WS_SX))
#define STATS ((float*)(ws + WS_STATS))
#define SWMAX ((unsigned*)(ws + WS_SWMAX))
#define ROPEH ((float*)(ws + WS_ROPEH))
#define ROPEI ((float*)(ws + WS_ROPEI))
#define TOK ((unsigned*)(ws + WS_TOK))
#define BCNT ((unsigned*)(ws + WS_BCNT))
#define META (BCNT + 256 * 8)
#define Hb ((bf16*)(ws + WS_H))
#define OA (ws + WS_OA)
#define OB (ws + WS_OB)
#define MG ((bf16*)(ws + WS_MG))
#define MASK ((unsigned long long*)(ws + WS_MASK))
#define SC ((float*)(ws + WS_SC))
#define HDb ((bf16*)(ws + WS_HD))
#define XGQ (ws + WS_XGQ)
#define SO ((bf16*)(ws + WS_SO))
#define HDM ((bf16*)(ws + WS_HDM))
#define SXG ((float*)(ws + WS_SXG))
#define PART ((float*)(ws + WS_PART))
    unsigned char* ws0 = (unsigned char*)ldptr(PT, 20);
    gu32* ctl = (gu32*)(ws0 + WS_CTL);
    XcdBarrier bar = xcd_barrier_post((unsigned*)(ctl + CW_BAR) + a_li * XCD_BAR_WORDS, MISC + 8);
    const int lo = MK_ONE_LAUNCH ? 0 : a_lo, hi = MK_ONE_LAUNCH ? N_PHASES : a_hi;
#define IN(k) (lo <= (k) && (k) < hi)
#ifndef MK_EXTRA_BAR
#define MK_EXTRA_BAR 0
#endif
#define SEAM(k) do { if ((k) + 1 < hi) xcd_barrier(bar); } while (0)

    if (PH_ON(11) && IN(0)) {
            const int tid = pg8::opqv(tid0), lane = tid & 63; (void)lane; unsigned char* ws = (unsigned char*)ldptr(PT, 20); (void)ws;
            for (int rep_ = REPN(0); rep_ > 0; --rep_) {
        for (int idx = gw; idx < 33536; idx += NGW) {
            int s, it; if (idx < 2048) { s = 4 + (idx >> 10); it = idx & 1023; } else if (idx < 4864) { s = 6; it = idx - 2048; } else { const int q = (idx - 4864) / 3584; s = 7 + q; it = idx - 4864 - q * 3584; }
            const float* src; bf16* dst; int K, N;
            if (s < 6) { src = ((const float*)ldptr(PT, 7)) + (size_t)(s - 4) * DM * DM; dst = WOUT_T + (size_t)(s - 4) * DM * DM; K = DM; N = DM; }
            else if (s == 6) { src = ((const float*)ldptr(PT, 12)); dst = FD_T; K = DFF; N = DM; }
            else { const int e = s - 7; src = ((const float*)ldptr(PT, 16)) + (size_t)e * DEXP * DM; dst = MD_T + (size_t)e * DM * DEXP; K = DEXP; N = DM; }
            tr_item(src, K, N, dst, 0, 0, it, lane);
        }
        for (int idx = gw * 64 + lane; idx < MTOK * 64; idx += NGW * 64) { const int m = idx >> 6, i = idx & 63;
            const float inv = exp2f(-(float)(2 * i) * (1.0f / 128.0f) * 13.287712379549449f); const float ang = (float)((const int*)ldptr(PT, 1))[m] * inv; float sn, cs; sincosf(ang, &sn, &cs);
            ROPEH[(size_t)idx * 2] = cs; ROPEH[(size_t)idx * 2 + 1] = sn; }
        for (int idx = gw * 64 + lane; idx < MTOK * 32; idx += NGW * 64) { const int m = idx >> 5, i = idx & 31;
            const float inv = exp2f(-(float)(2 * i) * (1.0f / 64.0f) * 13.287712379549449f); const float ang = (float)((const int*)ldptr(PT, 1))[m] * inv; float sn, cs; sincosf(ang, &sn, &cs);
            ROPEI[(size_t)idx * 2] = cs; ROPEI[(size_t)idx * 2 + 1] = sn; }
        for (int m = gw; m < MTOK; m += NGW) { f32x4 v[8]; load_row(v, ((const float*)ldptr(PT, 0)) + (size_t)m * DM, lane); ln_regs(v, ((const float*)ldptr(PT, 2)), ((const float*)ldptr(PT, 3)), lane, STATS + 2 * m); store_row(v, nullptr, XQ + (size_t)m * DM, SX + m, lane); }
            }
    }
    if (PH_ON(11) && IN(1)) {
        const int tid = pg8::opqv(tid0), lane = tid & 63; (void)lane; unsigned char* ws = (unsigned char*)ldptr(PT, 20); (void)ws;
        for (int rep_ = REPN(1); rep_ > 0; --rep_) {
        LAS unsigned* colmax = (LAS unsigned*)(lds + RING_OFF);
        for (int idx = blk; idx < 4774; idx += G) {
            int s_, it;
            if (idx < 710) { s_ = idx / 355; it = idx - s_ * 355; } else if (idx < 1062) { const int q = (idx - 710) / 176; s_ = 2 + q; it = idx - 710 - q * 176; }
            else if (idx < 4646) { const int q = (idx - 1062) / 224; s_ = 4 + q; it = idx - 1062 - q * 224; } else { s_ = 20 + ((idx - 4646) >> 5); it = (idx - 4646) & 31; }
            if (s_ >= 20) { const int l = (s_ - 20) & 1, pbm = (s_ - 20) >> 1;
                quant_tile(colmax, (pbm ? ((const float*)ldptr(PT, 6)) : ((const float*)ldptr(PT, 5))) + (size_t)l * 1024 * DM, 1024, DM, (pbm ? PBQ : PAQ) + (size_t)l * DM * 1024, SWMAX + (pbm ? SWM_PB : SWM_PA) + l * DM, 0, 0, it, tid); }
            else { const float* src; unsigned char* dst; int N, type, off = 0, so;
                if (s_ < 2) { src = ((const float*)ldptr(PT, 4)) + (size_t)s_ * DM * INCOLS; dst = WINQ + (size_t)s_ * LDH * DM; N = INCOLS; type = 2; so = SWM_WIN + s_ * LDH; }
                else if (s_ < 4) { src = (s_ == 2) ? ((const float*)ldptr(PT, 10)) : ((const float*)ldptr(PT, 11)); dst = FGUQ; N = DFF; type = 1; off = (s_ == 2) ? 0 : 128; so = SWM_FGU; }
                else { const int e = (s_ - 4) >> 1, up = (s_ - 4) & 1; src = (up ? ((const float*)ldptr(PT, 15)) : ((const float*)ldptr(PT, 14))) + (size_t)e * DM * DEXP; dst = MGUQ + (size_t)e * 2 * DEXP * DM; N = DEXP; type = 1; off = up ? 128 : 0; so = SWM_MGU + e * 2 * DEXP; }
                quant_tile(colmax, src, DM, N, dst, SWMAX + so, type, off, it, tid); }
        }
        }
        SEAM(1);
    }

    {
        constexpr int L = 0;
        const int pb = PRO_PH + PH_PER_LAYER * L;
        if (PH_ON(0) && IN(pb + 0)) {
            const int tid = pg8::opqv(tid0), lane = tid & 63; (void)lane; unsigned char* ws = (unsigned char*)ldptr(PT, 20); (void)ws;
            for (int rep_ = REPN(pb + 0); rep_ > 0; --rep_) {
            if (!MK_SKIP_MIXER) {
            for (int u = blk; u < 256; u += G) kiwi_task(lds + RING_OFF, XQ, WINQ + ((size_t)L * LDH + C_KI) * DM, SX, (const float*)(SWMAX + SWM_WIN + L * LDH), ROPEI, Hb, 64 * u, wave, tid);
            pg8::Gemm g{opq(XQ), opq(WINQ + (size_t)L * LDH * DM), MTOK, LDH - 256, DM, DM}; pg8::StaticOrder S; S.init(MTOK, LDH - 256, G, opqi(blk));
            pg8::EpiH E{Hb, LDH, ROPEH, ROPEI, SX, (const float*)(SWMAX + SWM_WIN + L * LDH), SWMAX + SWM_VMAX + 2 * L};
            pg8::gemm_phase<pg8::EpiH, pg8::StaticOrder, true, true>(lds + RING_OFF, g, S, E);
#ifdef MK_PROBE_NULLEPI
            { pg8::Gemm g2{opq(XQ), opq(WINQ + (size_t)L * LDH * DM), MTOK, LDH - 256, DM, DM}; pg8::StaticOrder S2; S2.init(MTOK, LDH - 256, G, opqi(blk));
#if MK_PROBE_NULLEPI == 2
              pg8::EpiDummyStoreI8 E2{(pg8::bf16_t*)SC}; pg8::gemm_phase<pg8::EpiDummyStoreI8, pg8::StaticOrder, true, true>(lds + RING_OFF, g2, S2, E2); }
#else
              pg8::EpiNullI8 E2; pg8::gemm_phase<pg8::EpiNullI8, pg8::StaticOrder, true, true>(lds + RING_OFF, g2, S2, E2); }
#endif
#endif
            }
            }
            SEAM(pb + 0);
        }
        if (PH_ON(1) && IN(pb + 1)) {
            const int tid = pg8::opqv(tid0), lane = tid & 63; (void)lane; unsigned char* ws = (unsigned char*)ldptr(PT, 20); (void)ws;
            for (int rep_ = REPN(pb + 1); rep_ > 0; --rep_) {
            if (!MK_SKIP_MIXER) {
#ifndef MK_REP_SUB
#define MK_REP_SUB 0
#endif
#ifndef MK_NO_IDX
            for (int r2 = ((MK_REP_SUB) & 1) ? 2 : 1; r2 > 0; --r2)
            for (int u = blk; u < 256; u += G) { const int b = u >> 6, cp = (u >> 1) & 31, h2 = u & 1;
                for (int k2 = 0; k2 < 2; ++k2) { const int c = k2 ? 63 - cp : cp;
                    score_task(lds + RING_OFF, Hb, SC, b, c, h2, wave, tid);
                    VM_WAIT();
                    for (int pp = 0; pp < 2; ++pp) select_task(SC, (unsigned*)MASK, b, c, 16 * h2 + 2 * wave + pp, lane); } }
#endif
#ifndef MK_NO_SB
            const float vmB = __uint_as_float(__builtin_amdgcn_readfirstlane(SWMAX[SWM_VMAX + 2 * L + 1])); const float oinvB = vmB > 0.f ? 127.0f / vmB : 0.f;
            for (int r2 = ((MK_REP_SUB) & 2) ? 2 : 1; r2 > 0; --r2)
            for (int u = blk; u < 256; u += G) { const int uu = (G == 256) ? (((u & 7) << 5) | (u >> 3)) : u;
                const int b = uu >> 6, h = (uu >> 3) & 7, s = uu & 7;
                for (int k2 = 0; k2 < 2; ++k2) att::attn_unit<1>(lds + RING_OFF, Hb, MASK, OB, oinvB, b, h, k2 ? 15 - s : s); }
#endif
            }
            }
            SEAM(pb + 1);
        }
        if (PH_ON(3) && IN(pb + 3)) {
            const int tid = pg8::opqv(tid0), lane = tid & 63; (void)lane; unsigned char* ws = (unsigned char*)ldptr(PT, 20); (void)ws;
            for (int rep_ = REPN(pb + 3); rep_ > 0; --rep_) {
            if (!MK_SKIP_MIXER) {
            const float vmA = __uint_as_float(__builtin_amdgcn_readfirstlane(SWMAX[SWM_VMAX + 2 * L])); const float oinvA = vmA > 0.f ? 127.0f / vmA : 0.f;
            for (int u = blk; u < 256; u += G) { const int uu = (G == 256) ? (((u & 7) << 5) | (u >> 3)) : u;
                const int b = uu >> 6, h = (uu >> 3) & 7, s = uu & 7;
                for (int k2 = 0; k2 < 2; ++k2) att::sparse_unit_p(lds + RING_OFF, Hb, MASK, OA, oinvA, b, h, k2 ? 15 - s : s); }
            }
            }
            SEAM(pb + 3);
        }
        if (PH_ON(4) && IN(pb + 4)) {
            const int tid = pg8::opqv(tid0), lane = tid & 63; (void)lane; unsigned char* ws = (unsigned char*)ldptr(PT, 20); (void)ws;
            for (int rep_ = REPN(pb + 4); rep_ > 0; --rep_) {
            if (!MK_SKIP_MIXER) {
            { pg8::Gemm g{opq(OA), opq(PAQ + (size_t)L * DM * 1024), MTOK, DM, 1024, 1024}; pg8::StaticOrder S; S.init(MTOK, DM, G, opqi(blk));
              pg8::EpiGate<0> E{MG, DM, Hb + C_GA, LDH, (const float*)(SWMAX + SWM_VMAX + 2 * L), (const float*)(SWMAX + SWM_PA + L * DM)};
              pg8::gemm_phase<pg8::EpiGate<0>, pg8::StaticOrder, true, true>(lds + RING_OFF, g, S, E); }
            { pg8::Gemm g{opq(OB), opq(PBQ + (size_t)L * DM * 1024), MTOK, DM, 1024, 1024}; pg8::StaticOrder S; S.init(MTOK, DM, G, opqi(blk));
              pg8::EpiGate<1> E{MG, DM, Hb + C_GB, LDH, (const float*)(SWMAX + SWM_VMAX + 2 * L + 1), (const float*)(SWMAX + SWM_PB + L * DM)};
              pg8::gemm_phase<pg8::EpiGate<1>, pg8::StaticOrder, true, true>(lds + RING_OFF, g, S, E); }
            }
            }
            SEAM(pb + 4);
        }
        if (PH_ON(5) && IN(pb + 5)) {
            const int tid = pg8::opqv(tid0), lane = tid & 63; (void)lane; unsigned char* ws = (unsigned char*)ldptr(PT, 20); (void)ws;
            for (int rep_ = REPN(pb + 5); rep_ > 0; --rep_) {
            if (!MK_SKIP_MIXER) {
            pg8::Gemm g{opq(MG), opq(WOUT_T + (size_t)L * DM * DM), MTOK, DM, 2 * DM, 2 * DM}; pg8::StaticOrder S; S.init(MTOK, DM, G, opqi(blk));
            pg8::EpiResid<L == 0> E{PT, 21 * L, 21, 22, 2 + 15 * L, 3 + 15 * L, DM, DN_ALPHA};
            pg8::gemm_phase<pg8::EpiResid<L == 0>, pg8::StaticOrder, true, true>(lds + RING_OFF, g, S, E);
            }
            }
            SEAM(pb + 5);
        }
        if (PH_ON(6) && IN(pb + 6)) {
            const int tid = pg8::opqv(tid0), lane = tid & 63; (void)lane; unsigned char* ws = (unsigned char*)ldptr(PT, 20); (void)ws;
            for (int rep_ = REPN(pb + 6); rep_ > 0; --rep_) {
            LAS unsigned* cntw = (LAS unsigned*)(lds + RING_OFF);
            f32x4 gg[8], bb[8];
#pragma unroll
            for (int j = 0; j < 8; ++j) { gg[j] = *((const f32x4*)(((const float*)ldptr(PT, 8)) + L * DM) + lane + 64 * j); bb[j] = *((const f32x4*)(((const float*)ldptr(PT, 9)) + L * DM) + lane + 64 * j); }
            for (int rb = blk; rb < MTOK / 64; rb += G) {
                if (L == 1) { if (tid < 64) cntw[tid] = 0u;
                    for (int n = tid; n < 4096; n += NWAVES * 64) { const int k = n >> 1, hf = n & 1, ln_ = (k >> 2) & 63, j = k >> 8, q = k & 3;
                        *(LAS f32x4*)(lds + RING_OFF + 1024 + (((j * 8 + q * 2 + hf) * 64 + ln_) << 4)) = *((const f32x4*)ldptr(PT, 13) + n); }
                    LDS_WAIT(); __syncthreads(); }
                unsigned my_info = 0u; float my_g1 = 0.f;
                v2u nx[8];
                { const v2u* rp0 = (const v2u*)(XS + (size_t)(rb * 64 + wave * 8) * DM);
#pragma unroll
                  for (int j = 0; j < 8; ++j) nx[j] = rp0[lane + 64 * j]; }
                for (int i = 0; i < 8; ++i) {
                    const int m = rb * 64 + wave * 8 + i;
                    f32x4 v[8];
#pragma unroll
                    for (int j = 0; j < 8; ++j) v[j] = (f32x4){bflo(nx[j].x), bfhi(nx[j].x), bflo(nx[j].y), bfhi(nx[j].y)};
                    if (i + 1 < 8) { const v2u* rpn = (const v2u*)(XS + (size_t)(m + 1) * DM);
#pragma unroll
                        for (int j = 0; j < 8; ++j) nx[j] = rpn[lane + 64 * j]; }
                    if (MK_SKIP_MIXER) {
#pragma unroll
                        for (int j = 0; j < 8; ++j) v[j] = v[j] * DN_ALPHA;
                    }
                    ln_regs_r(v, gg, bb, lane, STATS + 2 * m); store_row(v, nullptr, XQ + (size_t)m * DM, SX + m, lane);
                    if (L == 1) {
                        float lg[8];
#pragma unroll
                        for (int e = 0; e < 8; ++e) lg[e] = 0.f;
#pragma unroll
                        for (int j = 0; j < 8; ++j) { LAS const f32x4* rp = (LAS const f32x4*)(lds + RING_OFF + 1024) + (j * 8) * 64 + lane;
#pragma unroll
                            for (int q = 0; q < 4; ++q) { const f32x4 r0 = rp[(2 * q) * 64], r1 = rp[(2 * q + 1) * 64]; const float xv = v[j][q];
                                lg[0] = fmaf(xv, r0.x, lg[0]); lg[1] = fmaf(xv, r0.y, lg[1]); lg[2] = fmaf(xv, r0.z, lg[2]); lg[3] = fmaf(xv, r0.w, lg[3]);
                                lg[4] = fmaf(xv, r1.x, lg[4]); lg[5] = fmaf(xv, r1.y, lg[5]); lg[6] = fmaf(xv, r1.z, lg[6]); lg[7] = fmaf(xv, r1.w, lg[7]); } }
#pragma unroll
                        for (int e = 0; e < 8; ++e) lg[e] = wave_sum(lg[e]);
                        int e1 = 0; float v1 = lg[0];
#pragma unroll
                        for (int e = 1; e < 8; ++e) if (lg[e] > v1) { v1 = lg[e]; e1 = e; }
                        int e2 = -1; float v2 = -__builtin_inff();
#pragma unroll
                        for (int e = 0; e < 8; ++e) if (e != e1 && lg[e] > v2) { v2 = lg[e]; e2 = e; }
                        const float g1 = 1.0f / (1.0f + __expf(v2 - v1));
                        if (lane == 0) { const unsigned r1 = cntw[wave * 8 + e1]; cntw[wave * 8 + e1] = r1 + 1u; const unsigned r2 = cntw[wave * 8 + e2]; cntw[wave * 8 + e2] = r2 + 1u;
                            my_info = (unsigned)e1 | ((unsigned)e2 << 4) | (r1 << 8) | (r2 << 16); my_g1 = g1; }
                        const unsigned inf_b = __builtin_amdgcn_readfirstlane(my_info); const float g_b = __uint_as_float(__builtin_amdgcn_readfirstlane(__float_as_uint(my_g1)));
                        if (lane == 8 + i) { my_info = inf_b; my_g1 = g_b; }
                    }
                }
                if (L == 1) {
                    LDS_WAIT(); __syncthreads();
                    if (lane >= 8 && lane < 16) { const int i = lane - 8; const int m = rb * 64 + wave * 8 + i;
                        const int e1 = my_info & 15, e2 = (my_info >> 4) & 15; unsigned r1 = (my_info >> 8) & 255u, r2 = (my_info >> 16) & 255u;
                        for (int w2 = 0; w2 < wave; ++w2) { r1 += cntw[w2 * 8 + e1]; r2 += cntw[w2 * 8 + e2]; }
                        v4u rec; rec.x = (unsigned)e1 | ((unsigned)e2 << 4) | (r1 << 8) | (r2 << 16); rec.y = __float_as_uint(my_g1); rec.z = 0u; rec.w = 0u;
                        *(v4u*)(TOK + (size_t)m * 4) = rec; }
                    if (tid < 8) { unsigned c = 0u; for (int w2 = 0; w2 < 8; ++w2) c += cntw[w2 * 8 + tid]; BCNT[rb * 8 + tid] = c; }
                    __syncthreads();
                }
            }
            }
            SEAM(pb + 6);
        }
        if (L == 0) {
            if (PH_ON(7) && IN(pb + 7)) {
            const int tid = pg8::opqv(tid0), lane = tid & 63; (void)lane; unsigned char* ws = (unsigned char*)ldptr(PT, 20); (void)ws;
            for (int rep_ = REPN(pb + 7); rep_ > 0; --rep_) {
                pg8::Gemm g{opq(XQ), opq(FGUQ), MTOK, 2 * DFF, DM, DM}; pg8::StaticOrder S; S.init(MTOK, 2 * DFF, G, opqi(blk));
                pg8::EpiSwiglu E{HDb, DFF, SX, (const float*)(SWMAX + SWM_FGU)};
                pg8::gemm_phase<pg8::EpiSwiglu, pg8::StaticOrder, true, true>(lds + RING_OFF, g, S, E);
            }
                SEAM(pb + 7);
            }
            if (PH_ON(8) && IN(pb + 8)) {
            const int tid = pg8::opqv(tid0), lane = tid & 63; (void)lane; unsigned char* ws = (unsigned char*)ldptr(PT, 20); (void)ws;
            for (int rep_ = REPN(pb + 8); rep_ > 0; --rep_) {
                pg8::Gemm g{opq(HDb), opq(FD_T), MTOK, DM, 2 * DFF, 2 * DFF}; pg8::StaticOrder S; S.init(MTOK, DM, G, opqi(blk));
                pg8::EpiResid<false> E{PT, 21, 21, 22, 8, 9, DM, DN_ALPHA};
                pg8::gemm_phase<pg8::EpiResid<false>, pg8::StaticOrder, true, true>(lds + RING_OFF, g, S, E);
            }
                SEAM(pb + 8);
            }
            if (PH_ON(9) && IN(pb + 9)) {
            const int tid = pg8::opqv(tid0), lane = tid & 63; (void)lane; unsigned char* ws = (unsigned char*)ldptr(PT, 20); (void)ws;
            for (int rep_ = REPN(pb + 9); rep_ > 0; --rep_) {
                f32x4 gg[8], bb[8];
#pragma unroll
                for (int j = 0; j < 8; ++j) { gg[j] = *((const f32x4*)ldptr(PT, 17) + lane + 64 * j); bb[j] = *((const f32x4*)ldptr(PT, 18) + lane + 64 * j); }
                v2u nx[8];
                if (gw < MTOK) { const v2u* rp0 = (const v2u*)(XS + (size_t)gw * DM);
#pragma unroll
                    for (int j = 0; j < 8; ++j) nx[j] = rp0[lane + 64 * j]; }
                for (int m = gw; m < MTOK; m += NGW) { f32x4 v[8];
#pragma unroll
                    for (int j = 0; j < 8; ++j) v[j] = (f32x4){bflo(nx[j].x), bfhi(nx[j].x), bflo(nx[j].y), bfhi(nx[j].y)};
                    if (m + NGW < MTOK) { const v2u* rpn = (const v2u*)(XS + (size_t)(m + NGW) * DM);
#pragma unroll
                        for (int j = 0; j < 8; ++j) nx[j] = rpn[lane + 64 * j]; }
                    ln_regs_r(v, gg, bb, lane, STATS + 2 * m); store_row(v, nullptr, XQ + (size_t)m * DM, SX + m, lane); }
            }
                SEAM(pb + 9);
            }
        } else {
            if (PH_ON(7) && IN(pb + 7)) {
            const int tid = pg8::opqv(tid0), lane = tid & 63; (void)lane; unsigned char* ws = (unsigned char*)ldptr(PT, 20); (void)ws;
            for (int rep_ = REPN(pb + 7); rep_ > 0; --rep_) {
                LAS unsigned* red = (LAS unsigned*)(lds + RING_OFF);
                for (int rb = blk; rb < MTOK / 64; rb += G) {
                    if (tid < 16) red[tid] = 0u;
                    __syncthreads();
                    if (tid < 256) { const v4u c0 = *(const v4u*)(BCNT + tid * 8), c1 = *(const v4u*)(BCNT + tid * 8 + 4); const unsigned cc[8] = {c0.x, c0.y, c0.z, c0.w, c1.x, c1.y, c1.z, c1.w};
#pragma unroll
                        for (int e = 0; e < 8; ++e) { atomicAdd((unsigned*)&red[e], cc[e]); if (tid < rb) atomicAdd((unsigned*)&red[8 + e], cc[e]); } }
                    __syncthreads();
                    unsigned toff[9]; toff[0] = 0u;
#pragma unroll
                    for (int e = 0; e < 8; ++e) toff[e + 1] = toff[e] + ((red[e] + 255u) >> 8);
                    if (rb == 0 && tid < 9) { unsigned tv = 0u;
#pragma unroll
                        for (int e = 0; e < 9; ++e) tv = (tid == e) ? toff[e] : tv;
                        META[tid] = tv; }
                    if (lane < 8) {
                        const int m = rb * 64 + wave * 8 + lane; v4u rec = *(const v4u*)(TOK + (size_t)m * 4);
                        const int e1 = rec.x & 15, e2 = (rec.x >> 4) & 15; const unsigned r1 = (rec.x >> 8) & 255u, r2 = (rec.x >> 16) & 255u;
                        unsigned s1 = 0u, s2 = 0u;
#pragma unroll
                        for (int e = 0; e < 8; ++e) { const unsigned base = toff[e] * 256u + red[8 + e]; s1 = (e == e1) ? base + r1 : s1; s2 = (e == e2) ? base + r2 : s2; }
                        rec.z = s1; rec.w = s2; *(v4u*)(TOK + (size_t)m * 4) = rec;
                        MISC[16 + wave * 16 + lane * 2] = s1; MISC[16 + wave * 16 + lane * 2 + 1] = s2; }
                    LDS_WAIT();
                    { v4u tq[8][2]; float sxv[8];
#pragma unroll
                      for (int i = 0; i < 8; ++i) { const int m = rb * 64 + wave * 8 + i; const v4u* src = (const v4u*)(XQ + (size_t)m * DM); tq[i][0] = src[lane]; tq[i][1] = src[lane + 64]; sxv[i] = SX[m]; }
#pragma unroll
                      for (int i = 0; i < 8; ++i) { const unsigned s1 = MISC[16 + wave * 16 + i * 2], s2 = MISC[16 + wave * 16 + i * 2 + 1];
                        v4u* d1 = (v4u*)(XGQ + (size_t)s1 * DM); v4u* d2 = (v4u*)(XGQ + (size_t)s2 * DM);
                        d1[lane] = tq[i][0]; d1[lane + 64] = tq[i][1]; d2[lane] = tq[i][0]; d2[lane + 64] = tq[i][1];
                        if (lane == 0) { SXG[s1] = sxv[i]; SXG[s2] = sxv[i]; } } }
                    __syncthreads();
                }
            }
                SEAM(pb + 7);
            }
            if (PH_ON(8) && IN(pb + 8)) {
            const int tid = pg8::opqv(tid0), lane = tid & 63; (void)lane; unsigned char* ws = (unsigned char*)ldptr(PT, 20); (void)ws;
            for (int rep_ = REPN(pb + 8); rep_ > 0; --rep_) {
                pg8::GroupedOrder S; S.nN = 2 * DEXP / 256; S.G = G; S.c = opqi(blk);
#pragma unroll
                for (int e = 0; e < 9; ++e) S.toff[e] = (int)__builtin_amdgcn_readfirstlane(META[e]);
                S.nM = S.toff[8]; S.nwg = S.nM * S.nN;
                pg8::Gemm g{opq(XGQ), opq(MGUQ), S.nM * 256, 2 * DEXP, DM, DM};
                pg8::EpiSwiglu E{HDM, DEXP, SXG, (const float*)(SWMAX + SWM_MGU)};
                pg8::gemm_phase<pg8::EpiSwiglu, pg8::GroupedOrder, true, true>(lds + RING_OFF, g, S, E);
            }
                SEAM(pb + 8);
            }
            if (PH_ON(9) && IN(pb + 9)) {
            const int tid = pg8::opqv(tid0), lane = tid & 63; (void)lane; unsigned char* ws = (unsigned char*)ldptr(PT, 20); (void)ws;
            for (int rep_ = REPN(pb + 9); rep_ > 0; --rep_) {
                int toffv[9];
#pragma unroll
                for (int e = 0; e < 9; ++e) toffv[e] = (int)__builtin_amdgcn_readfirstlane(META[e]);
                const int nMt = toffv[8], nr = nMt & 31, nMf = nMt - nr;
                { pg8::GroupedOrder S; S.nN = DM / 256; S.G = G; S.c = opqi(blk);
#pragma unroll
                  for (int e = 0; e < 9; ++e) S.toff[e] = toffv[e];
                  S.nM = nMf; S.nwg = S.nM * S.nN;
                  pg8::Gemm g{opq(HDM), opq(MD_T), nMf * 256, DM, 2 * DEXP, 2 * DEXP};
                  pg8::EpiStoreBf16 E{SO, DM};
                  pg8::gemm_phase<pg8::EpiStoreBf16, pg8::GroupedOrder, true, true>(lds + RING_OFF, g, S, E); }
                if (nr > 0) { pg8::SplitOrder S; S.pm0 = nMf; S.nr = nr; S.nN = DM / 256; S.nch = 7; S.kbytes = 2 * 1024; S.nwg = nr * (DM / 256) * 7; S.G = G; S.c = opqi(blk);
#pragma unroll
                  for (int e = 0; e < 9; ++e) S.toff[e] = toffv[e];
                  pg8::Gemm g{opq(HDM), opq(MD_T), nMt * 256, DM, 2 * DEXP, 2 * 1024};
                  pg8::EpiPartialF32 E{PART, DM};
                  pg8::gemm_phase<pg8::EpiPartialF32, pg8::SplitOrder, true, true>(lds + RING_OFF, g, S, E); }
            }
                SEAM(pb + 9);
            }
            if (PH_ON(10) && IN(pb + 10)) {
            const int tid = pg8::opqv(tid0), lane = tid & 63; (void)lane; unsigned char* ws = (unsigned char*)ldptr(PT, 20); (void)ws;
            for (int rep_ = REPN(pb + 10); rep_ > 0; --rep_) {
                const int nMt10 = (int)__builtin_amdgcn_readfirstlane(META[8]); const int split0 = (nMt10 - (nMt10 & 31)) * 256;
                v4u recA = (v4u){0u, 0u, 0u, 0u}, recB = recA;
                v2u nx[8], np1[8], np2[8];
#pragma unroll
                for (int j = 0; j < 8; ++j) { nx[j] = (v2u){0u, 0u}; np1[j] = (v2u){0u, 0u}; np2[j] = (v2u){0u, 0u}; }
#define CMB_ROWS(M_, REC_) do { \
                    { const v2u* xp_ = (const v2u*)(XS + (size_t)(M_) * DM); \
                      _Pragma("unroll") for (int j = 0; j < 8; ++j) nx[j] = xp_[lane + 64 * j]; } \
                    _Pragma("unroll") for (int j = 0; j < 8; ++j) { np1[j] = (v2u){0u, 0u}; np2[j] = (v2u){0u, 0u}; } \
                    if ((int)(REC_).z < split0) { const v2u* sp_ = (const v2u*)(SO + (size_t)(REC_).z * DM); \
                        _Pragma("unroll") for (int j = 0; j < 8; ++j) np1[j] = sp_[lane + 64 * j]; } \
                    if ((int)(REC_).w < split0) { const v2u* sp_ = (const v2u*)(SO + (size_t)(REC_).w * DM); \
                        _Pragma("unroll") for (int j = 0; j < 8; ++j) np2[j] = sp_[lane + 64 * j]; } } while (0)
                if (gw < MTOK) { recB = *(const v4u*)(TOK + (size_t)gw * 4); CMB_ROWS(gw, recB); }
                if (gw + NGW < MTOK) recA = *(const v4u*)(TOK + (size_t)(gw + NGW) * 4);
                for (int m = gw; m < MTOK; m += NGW) {
                    const v4u rec = recB; const float g1 = __uint_as_float(rec.y), g2 = 1.0f - g1;
                    f32x4 v[8]; v2u p1[8], p2[8];
#pragma unroll
                    for (int j = 0; j < 8; ++j) { v[j] = (f32x4){bflo(nx[j].x), bfhi(nx[j].x), bflo(nx[j].y), bfhi(nx[j].y)}; p1[j] = np1[j]; p2[j] = np2[j]; }
                    const bool s1b = (int)rec.z < split0, s2b = (int)rec.w < split0;
                    recB = recA;
                    if (m + NGW < MTOK) CMB_ROWS(m + NGW, recB);
                    if (m + 2 * NGW < MTOK) recA = *(const v4u*)(TOK + (size_t)(m + 2 * NGW) * 4);
                    ln_regs(v, ((const float*)ldptr(PT, 8)) + DM, ((const float*)ldptr(PT, 9)) + DM, lane);
#pragma unroll
                    for (int j = 0; j < 8; ++j) { v[j] = v[j] * DN_ALPHA;
                        v[j].x += g1 * bflo(p1[j].x) + g2 * bflo(p2[j].x); v[j].y += g1 * bfhi(p1[j].x) + g2 * bfhi(p2[j].x); v[j].z += g1 * bflo(p1[j].y) + g2 * bflo(p2[j].y); v[j].w += g1 * bfhi(p1[j].y) + g2 * bfhi(p2[j].y); }
#pragma unroll
                    for (int k2 = 0; k2 < 2; ++k2) { const unsigned slot = k2 ? rec.w : rec.z; const float gk = k2 ? g2 : g1; const bool sb = k2 ? s2b : s1b;
                        if (!sb) { const float* pp = PART + (size_t)((int)slot - split0) * DM;
#pragma unroll 1
                            for (int kch = 0; kch < 7; ++kch) {
#pragma unroll
                                for (int j = 0; j < 8; ++j) v[j] += *((const f32x4*)(pp + (size_t)kch * 2048 * DM) + lane + 64 * j) * gk; } } }
                    ln_regs(v, ((const float*)ldptr(PT, 17)) + DM, ((const float*)ldptr(PT, 18)) + DM, lane); store_row(v, ((float*)ldptr(PT, 19)) + (size_t)m * DM, nullptr, nullptr, lane);
                }
#undef CMB_ROWS
            }
            }
        }
    }
    {
        constexpr int L = 1;
        const int pb = PRO_PH + PH_PER_LAYER * L;
        if (PH_ON(0) && IN(pb + 0)) {
            const int tid = pg8::opqv(tid0), lane = tid & 63; (void)lane; unsigned char* ws = (unsigned char*)ldptr(PT, 20); (void)ws;
            for (int rep_ = REPN(pb + 0); rep_ > 0; --rep_) {
            if (!MK_SKIP_MIXER) {
            for (int u = blk; u < 256; u += G) kiwi_task(lds + RING_OFF, XQ, WINQ + ((size_t)L * LDH + C_KI) * DM, SX, (const float*)(SWMAX + SWM_WIN + L * LDH), ROPEI, Hb, 64 * u, wave, tid);
            pg8::Gemm g{opq(XQ), opq(WINQ + (size_t)L * LDH * DM), MTOK, LDH - 256, DM, DM}; pg8::StaticOrder S; S.init(MTOK, LDH - 256, G, opqi(blk));
            pg8::EpiH E{Hb, LDH, ROPEH, ROPEI, SX, (const float*)(SWMAX + SWM_WIN + L * LDH), SWMAX + SWM_VMAX + 2 * L};
            pg8::gemm_phase<pg8::EpiH, pg8::StaticOrder, true, true>(lds + RING_OFF, g, S, E);
#ifdef MK_PROBE_NULLEPI
            { pg8::Gemm g2{opq(XQ), opq(WINQ + (size_t)L * LDH * DM), MTOK, LDH - 256, DM, DM}; pg8::StaticOrder S2; S2.init(MTOK, LDH - 256, G, opqi(blk));
#if MK_PROBE_NULLEPI == 2
              pg8::EpiDummyStoreI8 E2{(pg8::bf16_t*)SC}; pg8::gemm_phase<pg8::EpiDummyStoreI8, pg8::StaticOrder, true, true>(lds + RING_OFF, g2, S2, E2); }
#else
              pg8::EpiNullI8 E2; pg8::gemm_phase<pg8::EpiNullI8, pg8::StaticOrder, true, true>(lds + RING_OFF, g2, S2, E2); }
#endif
#endif
            }
            }
            SEAM(pb + 0);
        }
        if (PH_ON(1) && IN(pb + 1)) {
            const int tid = pg8::opqv(tid0), lane = tid & 63; (void)lane; unsigned char* ws = (unsigned char*)ldptr(PT, 20); (void)ws;
            for (int rep_ = REPN(pb + 1); rep_ > 0; --rep_) {
            if (!MK_SKIP_MIXER) {
#ifndef MK_REP_SUB
#define MK_REP_SUB 0
#endif
#ifndef MK_NO_IDX
            for (int r2 = ((MK_REP_SUB) & 1) ? 2 : 1; r2 > 0; --r2)
            for (int u = blk; u < 256; u += G) { const int b = u >> 6, cp = (u >> 1) & 31, h2 = u & 1;
                for (int k2 = 0; k2 < 2; ++k2) { const int c = k2 ? 63 - cp : cp;
                    score_task(lds + RING_OFF, Hb, SC, b, c, h2, wave, tid);
                    VM_WAIT();
                    for (int pp = 0; pp < 2; ++pp) select_task(SC, (unsigned*)MASK, b, c, 16 * h2 + 2 * wave + pp, lane); } }
#endif
#ifndef MK_NO_SB
            const float vmB = __uint_as_float(__builtin_amdgcn_readfirstlane(SWMAX[SWM_VMAX + 2 * L + 1])); const float oinvB = vmB > 0.f ? 127.0f / vmB : 0.f;
            for (int r2 = ((MK_REP_SUB) & 2) ? 2 : 1; r2 > 0; --r2)
            for (int u = blk; u < 256; u += G) { const int uu = (G == 256) ? (((u & 7) << 5) | (u >> 3)) : u;
                const int b = uu >> 6, h = (uu >> 3) & 7, s = uu & 7;
                for (int k2 = 0; k2 < 2; ++k2) att::attn_unit<1>(lds + RING_OFF, Hb, MASK, OB, oinvB, b, h, k2 ? 15 - s : s); }
#endif
            }
            }
            SEAM(pb + 1);
        }
        if (PH_ON(3) && IN(pb + 3)) {
            const int tid = pg8::opqv(tid0), lane = tid & 63; (void)lane; unsigned char* ws = (unsigned char*)ldptr(PT, 20); (void)ws;
            for (int rep_ = REPN(pb + 3); rep_ > 0; --rep_) {
            if (!MK_SKIP_MIXER) {
            const float vmA = __uint_as_float(__builtin_amdgcn_readfirstlane(SWMAX[SWM_VMAX + 2 * L])); const float oinvA = vmA > 0.f ? 127.0f / vmA : 0.f;
            for (int u = blk; u < 256; u += G) { const int uu = (G == 256) ? (((u & 7) << 5) | (u >> 3)) : u;
                const int b = uu >> 6, h = (uu >> 3) & 7, s = uu & 7;
                for (int k2 = 0; k2 < 2; ++k2) att::sparse_unit_p(lds + RING_OFF, Hb, MASK, OA, oinvA, b, h, k2 ? 15 - s : s); }
            }
            }
            SEAM(pb + 3);
        }
        if (PH_ON(4) && IN(pb + 4)) {
            const int tid = pg8::opqv(tid0), lane = tid & 63; (void)lane; unsigned char* ws = (unsigned char*)ldptr(PT, 20); (void)ws;
            for (int rep_ = REPN(pb + 4); rep_ > 0; --rep_) {
            if (!MK_SKIP_MIXER) {
            { pg8::Gemm g{opq(OA), opq(PAQ + (size_t)L * DM * 1024), MTOK, DM, 1024, 1024}; pg8::StaticOrder S; S.init(MTOK, DM, G, opqi(blk));
              pg8::EpiGate<0> E{MG, DM, Hb + C_GA, LDH, (const float*)(SWMAX + SWM_VMAX + 2 * L), (const float*)(SWMAX + SWM_PA + L * DM)};
              pg8::gemm_phase<pg8::EpiGate<0>, pg8::StaticOrder, true, true>(lds + RING_OFF, g, S, E); }
            { pg8::Gemm g{opq(OB), opq(PBQ + (size_t)L * DM * 1024), MTOK, DM, 1024, 1024}; pg8::StaticOrder S; S.init(MTOK, DM, G, opqi(blk));
              pg8::EpiGate<1> E{MG, DM, Hb + C_GB, LDH, (const float*)(SWMAX + SWM_VMAX + 2 * L + 1), (const float*)(SWMAX + SWM_PB + L * DM)};
              pg8::gemm_phase<pg8::EpiGate<1>, pg8::StaticOrder, true, true>(lds + RING_OFF, g, S, E); }
            }
            }
            SEAM(pb + 4);
        }
        if (PH_ON(5) && IN(pb + 5)) {
            const int tid = pg8::opqv(tid0), lane = tid & 63; (void)lane; unsigned char* ws = (unsigned char*)ldptr(PT, 20); (void)ws;
            for (int rep_ = REPN(pb + 5); rep_ > 0; --rep_) {
            if (!MK_SKIP_MIXER) {
            pg8::Gemm g{opq(MG), opq(WOUT_T + (size_t)L * DM * DM), MTOK, DM, 2 * DM, 2 * DM}; pg8::StaticOrder S; S.init(MTOK, DM, G, opqi(blk));
            pg8::EpiResid<L == 0> E{PT, 21 * L, 21, 22, 2 + 15 * L, 3 + 15 * L, DM, DN_ALPHA};
            pg8::gemm_phase<pg8::EpiResid<L == 0>, pg8::StaticOrder, true, true>(lds + RING_OFF, g, S, E);
            }
            }
            SEAM(pb + 5);
        }
        if (PH_ON(6) && IN(pb + 6)) {
            const int tid = pg8::opqv(tid0), lane = tid & 63; (void)lane; unsigned char* ws = (unsigned char*)ldptr(PT, 20); (void)ws;
            for (int rep_ = REPN(pb + 6); rep_ > 0; --rep_) {
            LAS unsigned* cntw = (LAS unsigned*)(lds + RING_OFF);
            f32x4 gg[8], bb[8];
#pragma unroll
            for (int j = 0; j < 8; ++j) { gg[j] = *((const f32x4*)(((const float*)ldptr(PT, 8)) + L * DM) + lane + 64 * j); bb[j] = *((const f32x4*)(((const float*)ldptr(PT, 9)) + L * DM) + lane + 64 * j); }
            for (int rb = blk; rb < MTOK / 64; rb += G) {
                if (L == 1) { if (tid < 64) cntw[tid] = 0u;
                    for (int n = tid; n < 4096; n += NWAVES * 64) { const int k = n >> 1, hf = n & 1, ln_ = (k >> 2) & 63, j = k >> 8, q = k & 3;
                        *(LAS f32x4*)(lds + RING_OFF + 1024 + (((j * 8 + q * 2 + hf) * 64 + ln_) << 4)) = *((const f32x4*)ldptr(PT, 13) + n); }
                    LDS_WAIT(); __syncthreads(); }
                unsigned my_info = 0u; float my_g1 = 0.f;
                v2u nx[8];
                { const v2u* rp0 = (const v2u*)(XS + (size_t)(rb * 64 + wave * 8) * DM);
#pragma unroll
                  for (int j = 0; j < 8; ++j) nx[j] = rp0[lane + 64 * j]; }
                for (int i = 0; i < 8; ++i) {
                    const int m = rb * 64 + wave * 8 + i;
                    f32x4 v[8];
#pragma unroll
                    for (int j = 0; j < 8; ++j) v[j] = (f32x4){bflo(nx[j].x), bfhi(nx[j].x), bflo(nx[j].y), bfhi(nx[j].y)};
                    if (i + 1 < 8) { const v2u* rpn = (const v2u*)(XS + (size_t)(m + 1) * DM);
#pragma unroll
                        for (int j = 0; j < 8; ++j) nx[j] = rpn[lane + 64 * j]; }
                    if (MK_SKIP_MIXER) {
#pragma unroll
                        for (int j = 0; j < 8; ++j) v[j] = v[j] * DN_ALPHA;
                    }
                    ln_regs_r(v, gg, bb, lane, STATS + 2 * m); store_row(v, nullptr, XQ + (size_t)m * DM, SX + m, lane);
                    if (L == 1) {
                        float lg[8];
#pragma unroll
                        for (int e = 0; e < 8; ++e) lg[e] = 0.f;
#pragma unroll
                        for (int j = 0; j < 8; ++j) { LAS const f32x4* rp = (LAS const f32x4*)(lds + RING_OFF + 1024) + (j * 8) * 64 + lane;
#pragma unroll
                            for (int q = 0; q < 4; ++q) { const f32x4 r0 = rp[(2 * q) * 64], r1 = rp[(2 * q + 1) * 64]; const float xv = v[j][q];
                                lg[0] = fmaf(xv, r0.x, lg[0]); lg[1] = fmaf(xv, r0.y, lg[1]); lg[2] = fmaf(xv, r0.z, lg[2]); lg[3] = fmaf(xv, r0.w, lg[3]);
                                lg[4] = fmaf(xv, r1.x, lg[4]); lg[5] = fmaf(xv, r1.y, lg[5]); lg[6] = fmaf(xv, r1.z, lg[6]); lg[7] = fmaf(xv, r1.w, lg[7]); } }
#pragma unroll
                        for (int e = 0; e < 8; ++e) lg[e] = wave_sum(lg[e]);
                        int e1 = 0; float v1 = lg[0];
#pragma unroll
                        for (int e = 1; e < 8; ++e) if (lg[e] > v1) { v1 = lg[e]; e1 = e; }
                        int e2 = -1; float v2 = -__builtin_inff();
#pragma unroll
                        for (int e = 0; e < 8; ++e) if (e != e1 && lg[e] > v2) { v2 = lg[e]; e2 = e; }
                        const float g1 = 1.0f / (1.0f + __expf(v2 - v1));
                        if (lane == 0) { const unsigned r1 = cntw[wave * 8 + e1]; cntw[wave * 8 + e1] = r1 + 1u; const unsigned r2 = cntw[wave * 8 + e2]; cntw[wave * 8 + e2] = r2 + 1u;
                            my_info = (unsigned)e1 | ((unsigned)e2 << 4) | (r1 << 8) | (r2 << 16); my_g1 = g1; }
                        const unsigned inf_b = __builtin_amdgcn_readfirstlane(my_info); const float g_b = __uint_as_float(__builtin_amdgcn_readfirstlane(__float_as_uint(my_g1)));
                        if (lane == 8 + i) { my_info = inf_b; my_g1 = g_b; }
                    }
                }
                if (L == 1) {
                    LDS_WAIT(); __syncthreads();
                    if (lane >= 8 && lane < 16) { const int i = lane - 8; const int m = rb * 64 + wave * 8 + i;
                        const int e1 = my_info & 15, e2 = (my_info >> 4) & 15; unsigned r1 = (my_info >> 8) & 255u, r2 = (my_info >> 16) & 255u;
                        for (int w2 = 0; w2 < wave; ++w2) { r1 += cntw[w2 * 8 + e1]; r2 += cntw[w2 * 8 + e2]; }
                        v4u rec; rec.x = (unsigned)e1 | ((unsigned)e2 << 4) | (r1 << 8) | (r2 << 16); rec.y = __float_as_uint(my_g1); rec.z = 0u; rec.w = 0u;
                        *(v4u*)(TOK + (size_t)m * 4) = rec; }
                    if (tid < 8) { unsigned c = 0u; for (int w2 = 0; w2 < 8; ++w2) c += cntw[w2 * 8 + tid]; BCNT[rb * 8 + tid] = c; }
                    __syncthreads();
                }
            }
            }
            SEAM(pb + 6);
        }
        if (L == 0) {
            if (PH_ON(7) && IN(pb + 7)) {
            const int tid = pg8::opqv(tid0), lane = tid & 63; (void)lane; unsigned char* ws = (unsigned char*)ldptr(PT, 20); (void)ws;
            for (int rep_ = REPN(pb + 7); rep_ > 0; --rep_) {
                pg8::Gemm g{opq(XQ), opq(FGUQ), MTOK, 2 * DFF, DM, DM}; pg8::StaticOrder S; S.init(MTOK, 2 * DFF, G, opqi(blk));
                pg8::EpiSwiglu E{HDb, DFF, SX, (const float*)(SWMAX + SWM_FGU)};
                pg8::gemm_phase<pg8::EpiSwiglu, pg8::StaticOrder, true, true>(lds + RING_OFF, g, S, E);
            }
                SEAM(pb + 7);
            }
            if (PH_ON(8) && IN(pb + 8)) {
            const int tid = pg8::opqv(tid0), lane = tid & 63; (void)lane; unsigned char* ws = (unsigned char*)ldptr(PT, 20); (void)ws;
            for (int rep_ = REPN(pb + 8); rep_ > 0; --rep_) {
                pg8::Gemm g{opq(HDb), opq(FD_T), MTOK, DM, 2 * DFF, 2 * DFF}; pg8::StaticOrder S; S.init(MTOK, DM, G, opqi(blk));
                pg8::EpiResid<false> E{PT, 21, 21, 22, 8, 9, DM, DN_ALPHA};
                pg8::gemm_phase<pg8::EpiResid<false>, pg8::StaticOrder, true, true>(lds + RING_OFF, g, S, E);
            }
                SEAM(pb + 8);
            }
            if (PH_ON(9) && IN(pb + 9)) {
            const int tid = pg8::opqv(tid0), lane = tid & 63; (void)lane; unsigned char* ws = (unsigned char*)ldptr(PT, 20); (void)ws;
            for (int rep_ = REPN(pb + 9); rep_ > 0; --rep_) {
                f32x4 gg[8], bb[8];
#pragma unroll
                for (int j = 0; j < 8; ++j) { gg[j] = *((const f32x4*)ldptr(PT, 17) + lane + 64 * j); bb[j] = *((const f32x4*)ldptr(PT, 18) + lane + 64 * j); }
                v2u nx[8];
                if (gw < MTOK) { const v2u* rp0 = (const v2u*)(XS + (size_t)gw * DM);
#pragma unroll
                    for (int j = 0; j < 8; ++j) nx[j] = rp0[lane + 64 * j]; }
                for (int m = gw; m < MTOK; m += NGW) { f32x4 v[8];
#pragma unroll
                    for (int j = 0; j < 8; ++j) v[j] = (f32x4){bflo(nx[j].x), bfhi(nx[j].x), bflo(nx[j].y), bfhi(nx[j].y)};
                    if (m + NGW < MTOK) { const v2u* rpn = (const v2u*)(XS + (size_t)(m + NGW) * DM);
#pragma unroll
                        for (int j = 0; j < 8; ++j) nx[j] = rpn[lane + 64 * j]; }
                    ln_regs_r(v, gg, bb, lane, STATS + 2 * m); store_row(v, nullptr, XQ + (size_t)m * DM, SX + m, lane); }
            }
                SEAM(pb + 9);
            }
        } else {
            if (PH_ON(7) && IN(pb + 7)) {
            const int tid = pg8::opqv(tid0), lane = tid & 63; (void)lane; unsigned char* ws = (unsigned char*)ldptr(PT, 20); (void)ws;
            for (int rep_ = REPN(pb + 7); rep_ > 0; --rep_) {
                LAS unsigned* red = (LAS unsigned*)(lds + RING_OFF);
                for (int rb = blk; rb < MTOK / 64; rb += G) {
                    if (tid < 16) red[tid] = 0u;
                    __syncthreads();
                    if (tid < 256) { const v4u c0 = *(const v4u*)(BCNT + tid * 8), c1 = *(const v4u*)(BCNT + tid * 8 + 4); const unsigned cc[8] = {c0.x, c0.y, c0.z, c0.w, c1.x, c1.y, c1.z, c1.w};
#pragma unroll
                        for (int e = 0; e < 8; ++e) { atomicAdd((unsigned*)&red[e], cc[e]); if (tid < rb) atomicAdd((unsigned*)&red[8 + e], cc[e]); } }
                    __syncthreads();
                    unsigned toff[9]; toff[0] = 0u;
#pragma unroll
                    for (int e = 0; e < 8; ++e) toff[e + 1] = toff[e] + ((red[e] + 255u) >> 8);
                    if (rb == 0 && tid < 9) { unsigned tv = 0u;
#pragma unroll
                        for (int e = 0; e < 9; ++e) tv = (tid == e) ? toff[e] : tv;
                        META[tid] = tv; }
                    if (lane < 8) {
                        const int m = rb * 64 + wave * 8 + lane; v4u rec = *(const v4u*)(TOK + (size_t)m * 4);
                        const int e1 = rec.x & 15, e2 = (rec.x >> 4) & 15; const unsigned r1 = (rec.x >> 8) & 255u, r2 = (rec.x >> 16) & 255u;
                        unsigned s1 = 0u, s2 = 0u;
#pragma unroll
                        for (int e = 0; e < 8; ++e) { const unsigned base = toff[e] * 256u + red[8 + e]; s1 = (e == e1) ? base + r1 : s1; s2 = (e == e2) ? base + r2 : s2; }
                        rec.z = s1; rec.w = s2; *(v4u*)(TOK + (size_t)m * 4) = rec;
                        MISC[16 + wave * 16 + lane * 2] = s1; MISC[16 + wave * 16 + lane * 2 + 1] = s2; }
                    LDS_WAIT();
                    { v4u tq[8][2]; float sxv[8];
#pragma unroll
                      for (int i = 0; i < 8; ++i) { const int m = rb * 64 + wave * 8 + i; const v4u* src = (const v4u*)(XQ + (size_t)m * DM); tq[i][0] = src[lane]; tq[i][1] = src[lane + 64]; sxv[i] = SX[m]; }
#pragma unroll
                      for (int i = 0; i < 8; ++i) { const unsigned s1 = MISC[16 + wave * 16 + i * 2], s2 = MISC[16 + wave * 16 + i * 2 + 1];
                        v4u* d1 = (v4u*)(XGQ + (size_t)s1 * DM); v4u* d2 = (v4u*)(XGQ + (size_t)s2 * DM);
                        d1[lane] = tq[i][0]; d1[lane + 64] = tq[i][1]; d2[lane] = tq[i][0]; d2[lane + 64] = tq[i][1];
                        if (lane == 0) { SXG[s1] = sxv[i]; SXG[s2] = sxv[i]; } } }
                    __syncthreads();
                }
            }
                SEAM(pb + 7);
            }
            if (PH_ON(8) && IN(pb + 8)) {
            const int tid = pg8::opqv(tid0), lane = tid & 63; (void)lane; unsigned char* ws = (unsigned char*)ldptr(PT, 20); (void)ws;
            for (int rep_ = REPN(pb + 8); rep_ > 0; --rep_) {
                pg8::GroupedOrder S; S.nN = 2 * DEXP / 256; S.G = G; S.c = opqi(blk);
#pragma unroll
                for (int e = 0; e < 9; ++e) S.toff[e] = (int)__builtin_amdgcn_readfirstlane(META[e]);
                S.nM = S.toff[8]; S.nwg = S.nM * S.nN;
                pg8::Gemm g{opq(XGQ), opq(MGUQ), S.nM * 256, 2 * DEXP, DM, DM};
                pg8::EpiSwiglu E{HDM, DEXP, SXG, (const float*)(SWMAX + SWM_MGU)};
                pg8::gemm_phase<pg8::EpiSwiglu, pg8::GroupedOrder, true, true>(lds + RING_OFF, g, S, E);
            }
                SEAM(pb + 8);
            }
            if (PH_ON(9) && IN(pb + 9)) {
            const int tid = pg8::opqv(tid0), lane = tid & 63; (void)lane; unsigned char* ws = (unsigned char*)ldptr(PT, 20); (void)ws;
            for (int rep_ = REPN(pb + 9); rep_ > 0; --rep_) {
                int toffv[9];
#pragma unroll
                for (int e = 0; e < 9; ++e) toffv[e] = (int)__builtin_amdgcn_readfirstlane(META[e]);
                const int nMt = toffv[8], nr = nMt & 31, nMf = nMt - nr;
                { pg8::GroupedOrder S; S.nN = DM / 256; S.G = G; S.c = opqi(blk);
#pragma unroll
                  for (int e = 0; e < 9; ++e) S.toff[e] = toffv[e];
                  S.nM = nMf; S.nwg = S.nM * S.nN;
                  pg8::Gemm g{opq(HDM), opq(MD_T), nMf * 256, DM, 2 * DEXP, 2 * DEXP};
                  pg8::EpiStoreBf16 E{SO, DM};
                  pg8::gemm_phase<pg8::EpiStoreBf16, pg8::GroupedOrder, true, true>(lds + RING_OFF, g, S, E); }
                if (nr > 0) { pg8::SplitOrder S; S.pm0 = nMf; S.nr = nr; S.nN = DM / 256; S.nch = 7; S.kbytes = 2 * 1024; S.nwg = nr * (DM / 256) * 7; S.G = G; S.c = opqi(blk);
#pragma unroll
                  for (int e = 0; e < 9; ++e) S.toff[e] = toffv[e];
                  pg8::Gemm g{opq(HDM), opq(MD_T), nMt * 256, DM, 2 * DEXP, 2 * 1024};
                  pg8::EpiPartialF32 E{PART, DM};
                  pg8::gemm_phase<pg8::EpiPartialF32, pg8::SplitOrder, true, true>(lds + RING_OFF, g, S, E); }
            }
                SEAM(pb + 9);
            }
            if (PH_ON(10) && IN(pb + 10)) {
            const int tid = pg8::opqv(tid0), lane = tid & 63; (void)lane; unsigned char* ws = (unsigned char*)ldptr(PT, 20); (void)ws;
            for (int rep_ = REPN(pb + 10); rep_ > 0; --rep_) {
                const int nMt10 = (int)__builtin_amdgcn_readfirstlane(META[8]); const int split0 = (nMt10 - (nMt10 & 31)) * 256;
                v4u recA = (v4u){0u, 0u, 0u, 0u}, recB = recA;
                v2u nx[8], np1[8], np2[8];
#pragma unroll
                for (int j = 0; j < 8; ++j) { nx[j] = (v2u){0u, 0u}; np1[j] = (v2u){0u, 0u}; np2[j] = (v2u){0u, 0u}; }
#define CMB_ROWS(M_, REC_) do { \
                    { const v2u* xp_ = (const v2u*)(XS + (size_t)(M_) * DM); \
                      _Pragma("unroll") for (int j = 0; j < 8; ++j) nx[j] = xp_[lane + 64 * j]; } \
                    _Pragma("unroll") for (int j = 0; j < 8; ++j) { np1[j] = (v2u){0u, 0u}; np2[j] = (v2u){0u, 0u}; } \
                    if ((int)(REC_).z < split0) { const v2u* sp_ = (const v2u*)(SO + (size_t)(REC_).z * DM); \
                        _Pragma("unroll") for (int j = 0; j < 8; ++j) np1[j] = sp_[lane + 64 * j]; } \
                    if ((int)(REC_).w < split0) { const v2u* sp_ = (const v2u*)(SO + (size_t)(REC_).w * DM); \
                        _Pragma("unroll") for (int j = 0; j < 8; ++j) np2[j] = sp_[lane + 64 * j]; } } while (0)
                if (gw < MTOK) { recB = *(const v4u*)(TOK + (size_t)gw * 4); CMB_ROWS(gw, recB); }
                if (gw + NGW < MTOK) recA = *(const v4u*)(TOK + (size_t)(gw + NGW) * 4);
                for (int m = gw; m < MTOK; m += NGW) {
                    const v4u rec = recB; const float g1 = __uint_as_float(rec.y), g2 = 1.0f - g1;
                    f32x4 v[8]; v2u p1[8], p2[8];
#pragma unroll
                    for (int j = 0; j < 8; ++j) { v[j] = (f32x4){bflo(nx[j].x), bfhi(nx[j].x), bflo(nx[j].y), bfhi(nx[j].y)}; p1[j] = np1[j]; p2[j] = np2[j]; }
                    const bool s1b = (int)rec.z < split0, s2b = (int)rec.w < split0;
                    recB = recA;
                    if (m + NGW < MTOK) CMB_ROWS(m + NGW, recB);
                    if (m + 2 * NGW < MTOK) recA = *(const v4u*)(TOK + (size_t)(m + 2 * NGW) * 4);
                    ln_regs(v, ((const float*)ldptr(PT, 8)) + DM, ((const float*)ldptr(PT, 9)) + DM, lane);
#pragma unroll
                    for (int j = 0; j < 8; ++j) { v[j] = v[j] * DN_ALPHA;
                        v[j].x += g1 * bflo(p1[j].x) + g2 * bflo(p2[j].x); v[j].y += g1 * bfhi(p1[j].x) + g2 * bfhi(p2[j].x); v[j].z += g1 * bflo(p1[j].y) + g2 * bflo(p2[j].y); v[j].w += g1 * bfhi(p1[j].y) + g2 * bfhi(p2[j].y); }
#pragma unroll
                    for (int k2 = 0; k2 < 2; ++k2) { const unsigned slot = k2 ? rec.w : rec.z; const float gk = k2 ? g2 : g1; const bool sb = k2 ? s2b : s1b;
                        if (!sb) { const float* pp = PART + (size_t)((int)slot - split0) * DM;
#pragma unroll 1
                            for (int kch = 0; kch < 7; ++kch) {
#pragma unroll
                                for (int j = 0; j < 8; ++j) v[j] += *((const f32x4*)(pp + (size_t)kch * 2048 * DM) + lane + 64 * j) * gk; } } }
                    ln_regs(v, ((const float*)ldptr(PT, 17)) + DM, ((const float*)ldptr(PT, 18)) + DM, lane); store_row(v, ((float*)ldptr(PT, 19)) + (size_t)m * DM, nullptr, nullptr, lane);
                }
#undef CMB_ROWS
            }
            }
        }
    }
#undef IN
#undef SEAM
#undef WINQ
#undef PAQ
#undef PBQ
#undef WOUT_T
#undef FGUQ
#undef FD_T
#undef MGUQ
#undef MD_T
#undef XS
#undef XQ
#undef SX
#undef STATS
#undef SWMAX
#undef ROPEH
#undef ROPEI
#undef TOK
#undef BCNT
#undef META
#undef Hb
#undef OA
#undef OB
#undef MG
#undef MASK
#undef SC
#undef HDb
#undef XGQ
#undef SO
#undef HDM
#undef SXG
#undef PART
}

extern "C" void kernel_launch(void* const* d_in, const int* in_sizes, int n_in, void* d_out, int out_size, void* d_ws, size_t ws_size, hipStream_t stream) {
    static int grid = 0;
    if (grid == 0) {
        if (n_in != 19 || out_size != MTOK * DM || ws_size < WS_END) { fprintf(stderr, "kernel_launch: unexpected shapes (n_in %d out %d ws %zu need %zu)\n", n_in, out_size, ws_size, (size_t)WS_END); grid = -1; return; }
        int dev = 0, cus = 0, per_cu = 0;
        if (hipGetDevice(&dev) != hipSuccess || hipDeviceGetAttribute(&cus, hipDeviceAttributeMultiprocessorCount, dev) != hipSuccess) { grid = -1; return; }
        if (hipFuncSetAttribute((const void*)fwd_kernel, hipFuncAttributeMaxDynamicSharedMemorySize, LDS_BYTES) != hipSuccess) { fprintf(stderr, "kernel_launch: hipFuncSetAttribute failed\n"); grid = -1; return; }
        if (hipOccupancyMaxActiveBlocksPerMultiprocessor(&per_cu, (const void*)fwd_kernel, NWAVES * 64, LDS_BYTES) != hipSuccess || per_cu < 1)
            fprintf(stderr, "kernel_launch: occupancy query reports %d workgroups per CU\n", per_cu);
        (void)hipGetLastError();
        grid = cus < 256 ? cus : 256;
    }
    if (grid < 0) return;
    (void)hipMemsetAsync((char*)d_ws + WS_CTL, 0, CTL_ZERO_BYTES, stream);
    Ptrs a{};
    a.x = (const float*)d_in[0]; a.pos = (const int*)d_in[1]; a.ln_in_g = (const float*)d_in[2]; a.ln_in_b = (const float*)d_in[3]; a.w_in = (const float*)d_in[4];
    a.w_proj_a = (const float*)d_in[5]; a.w_proj_b = (const float*)d_in[6]; a.w_out = (const float*)d_in[7]; a.ln_mix_g = (const float*)d_in[8]; a.ln_mix_b = (const float*)d_in[9];
    a.ffn_w_gate = (const float*)d_in[10]; a.ffn_w_up = (const float*)d_in[11]; a.ffn_w_down = (const float*)d_in[12]; a.router_w = (const float*)d_in[13];
    a.moe_w_gate = (const float*)d_in[14]; a.moe_w_up = (const float*)d_in[15]; a.moe_w_down = (const float*)d_in[16]; a.ln_ffn_g = (const float*)d_in[17]; a.ln_ffn_b = (const float*)d_in[18];
    a.out = (float*)d_out; a.ws = (unsigned char*)d_ws; a.pad = 0;
#if MK_ONE_LAUNCH
    a.ph_lo = 0; a.ph_hi = N_PHASES; a.li = 0;
    hipLaunchKernelGGL(fwd_kernel, dim3(grid), dim3(NWAVES * 64), LDS_BYTES, stream, a);
#else
    for (int p = 0; p < N_PHASES; ++p) { a.ph_lo = p; a.ph_hi = p + 1; a.li = p;
        hipLaunchKernelGGL(fwd_kernel, dim3(grid), dim3(NWAVES * 64), LDS_BYTES, stream, a); }
#endif
}
```

```cpp
#include <hip/hip_runtime.h>
#include <cstdio>
#include <cstdint>

namespace pg8 {
#define PG8_LAS __attribute__((address_space(3)))
typedef unsigned short bf16_t;
typedef short bf16x8 __attribute__((ext_vector_type(8)));
typedef float f32x4 __attribute__((ext_vector_type(4)));
typedef unsigned u32x4 __attribute__((ext_vector_type(4)));
typedef unsigned u32x2 __attribute__((ext_vector_type(2)));
typedef float f32x2 __attribute__((ext_vector_type(2)));
constexpr int BM = 256, BK = 64, HALF = 128, HTB = HALF * BK * 2  , STAGE_BYTES = 8 * HTB, NXCD = 8, WGM = 4;

__host__ __device__ __forceinline__ int lds_byte(int r, int c) { const int st = (r >> 4) * 2 + (c >> 5), rr = r & 15, cc = c & 31, ob = rr * 64 + cc * 2; return st * 1024 + (ob ^ (((ob >> 9) & 1) << 5)); }
__host__ __device__ __forceinline__ void stage_rc(int b, int& R, int& C) { const int st = b / 1024, sb = b % 1024, swz = sb ^ (((sb >> 9) & 1) << 5); R = (st >> 1) * 16 + swz / 64; C = (st & 1) * 32 + (swz % 64) / 2; }
__host__ __device__ __forceinline__ int perm32(int rho) { const int n = rho >> 4, i = rho & 15; return 8 * (i >> 2) + 4 * n + (i & 3); }

struct Unit { int pm, pn, pb, koff, aux; };
struct Gemm { const void* A; const void* Bt; int M, N, Kb, Kx; };
typedef int v4i __attribute__((ext_vector_type(4)));
template <int OPK> struct AccSel { typedef f32x4 T; };
template <> struct AccSel<1> { typedef v4i T; };

struct StaticOrder {
    int nM, nN, nwg, G, c;
    __host__ __device__ void init(int M, int N, int G_, int c_) { nM = M / BM; nN = N / BM; nwg = nM * nN; G = G_; c = c_; }
    __host__ __device__ bool next(int i, Unit& u) const {
        const long L = (long)i * G + c; if (L >= nwg) return false;
        int wgid = (int)L; { const int q = nwg / NXCD, r = nwg % NXCD, xcd = wgid % NXCD, off = wgid / NXCD; wgid = (xcd < r ? xcd * (q + 1) : r * (q + 1) + (xcd - r) * q) + off; }
        const int nig = WGM * nN, gid = wgid / nig, fm = gid * WGM, gsz = (nM - fm) < WGM ? (nM - fm) : WGM;
        u.pm = fm + ((wgid % nig) % gsz); u.pn = (wgid % nig) / gsz; u.pb = u.pn; u.koff = 0; u.aux = 0; return true;
    }
};
struct GroupedOrder {
    int nM, nN, nwg, G, c; int toff[9];
    __device__ bool next(int i, Unit& u) const {
        const long L = (long)i * G + c; if (L >= nwg) return false;
        int wgid = (int)L; { const int q = nwg / NXCD, r = nwg % NXCD, xcd = wgid % NXCD, off = wgid / NXCD; wgid = (xcd < r ? xcd * (q + 1) : r * (q + 1) + (xcd - r) * q) + off; }
        const int nig = WGM * nN, gid = wgid / nig, fm = gid * WGM, gsz = (nM - fm) < WGM ? (nM - fm) : WGM;
        u.pm = fm + ((wgid % nig) % gsz); u.pn = (wgid % nig) / gsz;
        int e = 0;
#pragma unroll
        for (int k = 1; k < 8; ++k) e += (u.pm >= toff[k]) ? 1 : 0;
        u.pb = e * nN + u.pn; u.koff = 0; u.aux = 0; return true;
    }
};
struct SplitOrder {
    int pm0, nr, nN, nch, kbytes, nwg, G, c; int toff[9];
    __device__ bool next(int i, Unit& u) const {
        const long L = (long)i * G + c; if (L >= nwg) return false;
        const int l = (int)L, kch = l % nch, rest = l / nch, pn = rest % nN, pmr = rest / nN;
        u.pm = pm0 + pmr; u.pn = pn;
        int e = 0;
#pragma unroll
        for (int k = 1; k < 8; ++k) e += (u.pm >= toff[k]) ? 1 : 0;
        u.pb = e * nN + pn; u.koff = kch * kbytes; u.aux = kch * 8 + pmr; return true;
    }
};
struct EpiPartialF32 {
    static constexpr bool PF = false; static constexpr int NST = 32; static constexpr bool PERM = false; static constexpr int OPK = 0;
    float* P; int ldc;
    __device__ __forceinline__ void operator()(const f32x4 (&acc)[2][2][4][2], const Unit& u, int wr, int wc, int fr, int fq) const {
        const int row0 = wr * 64 + fr, col0 = u.pn * BM + wc * 32 + 4 * fq;
        float* base = P + ((size_t)(u.aux >> 3) * 2048 + (size_t)(u.aux & 7) * 256) * ldc;
#pragma unroll
        for (int ai = 0; ai < 2; ++ai)
#pragma unroll
            for (int m = 0; m < 4; ++m) { float* rowp = base + (size_t)(row0 + ai * HALF + m * 16) * ldc + col0;
#pragma unroll
                for (int bj = 0; bj < 2; ++bj)
#pragma unroll
                    for (int n = 0; n < 2; ++n) *(f32x4*)(rowp + bj * HALF + n * 16) = acc[ai][bj][m][n]; }
    }
};


__device__ __forceinline__ unsigned cvt_pk_bf16(float lo, float hi) { unsigned r; asm volatile("v_cvt_pk_bf16_f32 %0, %1, %2" : "=v"(r) : "v"(lo), "v"(hi)); return r; }
__device__ __forceinline__ float bf_lo(unsigned w) { return __uint_as_float(w << 16); }
__device__ __forceinline__ float bf_hi(unsigned w) { return __uint_as_float(w & 0xffff0000u); }
__device__ __forceinline__ float sigmoidf_fast(float x) { return __builtin_amdgcn_rcpf(1.0f + __builtin_amdgcn_exp2f(-1.4426950408889634f * x)); }

struct EpiNullI8 {
    static constexpr bool PF = false; static constexpr int NST = 0; static constexpr bool PERM = true; static constexpr int OPK = 1;
    __device__ __forceinline__ void operator()(const v4i (&acc)[2][2][4][2], const Unit& u, int wr, int wc, int fr, int fq) const {
        (void)u; (void)wr; (void)wc; (void)fr; (void)fq;
#pragma unroll
        for (int ai = 0; ai < 2; ++ai)
#pragma unroll
            for (int bj = 0; bj < 2; ++bj)
#pragma unroll
                for (int m = 0; m < 4; ++m)
#pragma unroll
                    for (int n = 0; n < 2; ++n) asm volatile("" :: "v"(acc[ai][bj][m][n]));
    }
};
struct EpiDummyStoreI8 {
    static constexpr bool PF = false; static constexpr int NST = 16; static constexpr bool PERM = true; static constexpr int OPK = 1;
    bf16_t* O;
    __device__ __forceinline__ void operator()(const v4i (&acc)[2][2][4][2], const Unit& u, int wr, int wc, int fr, int fq) const {
        const int row0 = u.pm * BM + wr * 64 + fr, col0 = (u.pn * BM + wc * 32 + 8 * fq) & 4095;
#pragma unroll
        for (int ai = 0; ai < 2; ++ai)
#pragma unroll
            for (int m = 0; m < 4; ++m) { bf16_t* rowp = O + (size_t)(row0 + ai * HALF + m * 16) * 4096 + col0;
#pragma unroll
                for (int bj = 0; bj < 2; ++bj) { const f32x4 v0 = __builtin_convertvector(acc[ai][bj][m][0], f32x4), v1 = __builtin_convertvector(acc[ai][bj][m][1], f32x4);
                    u32x4 w; w.x = cvt_pk_bf16(v0[0], v0[1]); w.y = cvt_pk_bf16(v0[2], v0[3]); w.z = cvt_pk_bf16(v1[0], v1[1]); w.w = cvt_pk_bf16(v1[2], v1[3]);
                    *(u32x4*)(rowp + bj * HALF) = w; } }
    }
};
struct EpiStoreBf16 {
    static constexpr bool PF = false; static constexpr int NST = 16; static constexpr bool PERM = true; static constexpr int OPK = 0;
    bf16_t* O; int ldc;
    __device__ __forceinline__ void operator()(const f32x4 (&acc)[2][2][4][2], const Unit& u, int wr, int wc, int fr, int fq) const {
        const int row0 = u.pm * BM + wr * 64 + fr, col0 = u.pn * BM + wc * 32 + 8 * fq;
#pragma unroll
        for (int ai = 0; ai < 2; ++ai)
#pragma unroll
            for (int m = 0; m < 4; ++m) { bf16_t* rowp = O + (size_t)(row0 + ai * HALF + m * 16) * ldc + col0;
#pragma unroll
                for (int bj = 0; bj < 2; ++bj) { const f32x4 v0 = acc[ai][bj][m][0], v1 = acc[ai][bj][m][1];
                    u32x4 w; w.x = cvt_pk_bf16(v0[0], v0[1]); w.y = cvt_pk_bf16(v0[2], v0[3]); w.z = cvt_pk_bf16(v1[0], v1[1]); w.w = cvt_pk_bf16(v1[2], v1[3]);
                    *(u32x4*)(rowp + bj * HALF) = w; } }
    }
};
struct EpiH {
    static constexpr bool PF = true;  static constexpr int NST = 16; static constexpr bool PERM = true; static constexpr int OPK = 1;
    bf16_t* __restrict__ O; int ldc; const float* __restrict__ ropeH; const float* __restrict__ ropeI; const float* __restrict__ sx; const float* __restrict__ swmax; unsigned* __restrict__ vmaxw;
    __device__ __forceinline__ const float* pf_row(const Unit& u) const { return sx + u.pm * BM; }
    __device__ __forceinline__ const float* pf_col(const Unit& u) const { return swmax + u.pb * BM; }
    __device__ __forceinline__ void operator()(const v4i (&acc)[2][2][4][2], const Unit& u, int wr, int wc, int fr, int fq) const { pf(acc, u, wr, wc, fr, fq, nullptr); }
    __device__ __forceinline__ void pf(const v4i (&acc)[2][2][4][2], const Unit& u, int wr, int wc, int fr, int fq, const PG8_LAS unsigned char* prm) const {
        const int row0 = u.pm * BM + wr * 64 + fr, col0 = u.pn * BM + wc * 32 + 8 * fq;
        const int pn = u.pn;
        const int mode = pn < 8 ? 1 : ((pn >= 12 && pn < 16) ? 2 : 0);
        const int vsel = (pn >= 8 && pn < 12) ? 0 : ((pn >= 24 && pn < 28) ? 1 : -1);
        float vam = 0.f;
        f32x4 cs[2][2];
#pragma unroll
        for (int bj = 0; bj < 2; ++bj)
#pragma unroll
            for (int n = 0; n < 2; ++n) cs[bj][n] = (prm ? *(const PG8_LAS f32x4*)(prm + 1024 + (wc * 32 + 8 * fq + bj * HALF + 4 * n) * 4) : *(const f32x4*)(swmax + u.pb * BM + wc * 32 + 8 * fq + bj * HALF + 4 * n)) * (1.0f / 127.0f);
        float rsv[8];
#pragma unroll
        for (int r8 = 0; r8 < 8; ++r8) rsv[r8] = prm ? *(const PG8_LAS float*)(prm + (wr * 64 + fr + (r8 >> 2) * HALF + (r8 & 3) * 16) * 4) : sx[row0 + (r8 >> 2) * HALF + (r8 & 3) * 16];
#pragma unroll
        for (int ai = 0; ai < 2; ++ai) {
            f32x4 t0v[4], t1v[4];
#pragma unroll
            for (int m = 0; m < 4; ++m) { t0v[m] = (f32x4){1.f, 0.f, 1.f, 0.f}; t1v[m] = t0v[m]; }
            if (mode == 1) {
#pragma unroll
                for (int m = 0; m < 4; ++m) { const float* tab = ropeH + ((size_t)(row0 + ai * HALF + m * 16) * 64 + 4 * (4 * wc + fq)) * 2; t0v[m] = *(const f32x4*)tab; t1v[m] = *(const f32x4*)(tab + 4); } }
            else if (mode == 2) {
#pragma unroll
                for (int m = 0; m < 4; ++m) { const float* tab = ropeI + ((size_t)(row0 + ai * HALF + m * 16) * 32 + 4 * (4 * (wc & 1) + fq)) * 2; t0v[m] = *(const f32x4*)tab; t1v[m] = *(const f32x4*)(tab + 4); } }
#pragma unroll
            for (int m = 0; m < 4; ++m) { const int row = row0 + ai * HALF + m * 16; bf16_t* rowp = O + (size_t)row * ldc + col0;
                const float rs = rsv[ai * 4 + m];
                const f32x4 t0 = t0v[m], t1 = t1v[m];
#pragma unroll
                for (int bj = 0; bj < 2; ++bj) { f32x4 v0 = __builtin_convertvector(acc[ai][bj][m][0], f32x4) * cs[bj][0] * rs, v1 = __builtin_convertvector(acc[ai][bj][m][1], f32x4) * cs[bj][1] * rs;
                    if (mode != 0) {
                        const f32x4 c = (f32x4){t0[0], t0[2], t1[0], t1[2]}, sn = (f32x4){t0[1], t0[3], t1[1], t1[3]};
                        const f32x4 y0 = v0 * c - v1 * sn, y1 = v1 * c + v0 * sn; v0 = y0; v1 = y1; }
                    if (vsel >= 0) { const f32x4 a0 = __builtin_elementwise_abs(v0), a1 = __builtin_elementwise_abs(v1); vam = fmaxf(vam, fmaxf(fmaxf(fmaxf(a0[0], a0[1]), fmaxf(a0[2], a0[3])), fmaxf(fmaxf(a1[0], a1[1]), fmaxf(a1[2], a1[3])))); }
                    u32x4 w; w.x = cvt_pk_bf16(v0[0], v0[1]); w.y = cvt_pk_bf16(v0[2], v0[3]); w.z = cvt_pk_bf16(v1[0], v1[1]); w.w = cvt_pk_bf16(v1[2], v1[3]);
                    *(u32x4*)(rowp + bj * HALF) = w; } }
        }
        if (vsel >= 0) {
#pragma unroll
            for (int o = 1; o < 64; o <<= 1) vam = fmaxf(vam, __shfl_xor(vam, o));
            if ((fr | fq) == 0) atomicMax(vmaxw + vsel, __float_as_uint(vam * 1.00390625f));
        }
    }
};
template <int MODE> struct EpiGate {
    static constexpr bool PF = false; static constexpr int NST = 16; static constexpr bool PERM = true; static constexpr int OPK = 1;
    bf16_t* __restrict__ O; int ldc; const bf16_t* __restrict__ Gt; int ldg; const float* __restrict__ amaxA; const float* __restrict__ swmax;
    __device__ __forceinline__ void operator()(const v4i (&acc)[2][2][4][2], const Unit& u, int wr, int wc, int fr, int fq) const {
        const int row0 = u.pm * BM + wr * 64 + fr, col0 = u.pn * BM + wc * 32 + 8 * fq;
        const float sa = *amaxA * (1.0f / (127.0f * 127.0f));
        f32x4 cs[2][2];
#pragma unroll
        for (int bj = 0; bj < 2; ++bj)
#pragma unroll
            for (int n = 0; n < 2; ++n) cs[bj][n] = *(const f32x4*)(swmax + col0 + bj * HALF + 4 * n) * sa;
        constexpr int GR = MODE == 1 ? 2 : 4;
#pragma unroll
        for (int grp = 0; grp < 8 / GR; ++grp) {
            u32x4 gq[GR][2], oq[GR][2];
#pragma unroll
            for (int k = 0; k < GR; ++k) { const int r8 = grp * GR + k; const size_t row = (size_t)(row0 + (r8 >> 2) * HALF + (r8 & 3) * 16);
#pragma unroll
                for (int bj = 0; bj < 2; ++bj) { gq[k][bj] = *(const u32x4*)(Gt + row * ldg + col0 + bj * HALF); if (MODE == 1) oq[k][bj] = *(const u32x4*)(O + row * ldc + col0 + bj * HALF); } }
#pragma unroll
            for (int k = 0; k < GR; ++k) { const int r8 = grp * GR + k, ai = r8 >> 2, m = r8 & 3; const size_t row = (size_t)(row0 + ai * HALF + m * 16); bf16_t* rowp = O + row * ldc + col0;
#pragma unroll
                for (int bj = 0; bj < 2; ++bj) { const f32x4 v0 = __builtin_convertvector(acc[ai][bj][m][0], f32x4) * cs[bj][0], v1 = __builtin_convertvector(acc[ai][bj][m][1], f32x4) * cs[bj][1];
                    const u32x4 g = gq[k][bj];
                    float r[8];
                    r[0] = sigmoidf_fast(bf_lo(g.x)) * v0[0]; r[1] = sigmoidf_fast(bf_hi(g.x)) * v0[1]; r[2] = sigmoidf_fast(bf_lo(g.y)) * v0[2]; r[3] = sigmoidf_fast(bf_hi(g.y)) * v0[3];
                    r[4] = sigmoidf_fast(bf_lo(g.z)) * v1[0]; r[5] = sigmoidf_fast(bf_hi(g.z)) * v1[1]; r[6] = sigmoidf_fast(bf_lo(g.w)) * v1[2]; r[7] = sigmoidf_fast(bf_hi(g.w)) * v1[3];
                    if (MODE == 1) { const u32x4 o = oq[k][bj];
                        r[0] += bf_lo(o.x); r[1] += bf_hi(o.x); r[2] += bf_lo(o.y); r[3] += bf_hi(o.y); r[4] += bf_lo(o.z); r[5] += bf_hi(o.z); r[6] += bf_lo(o.w); r[7] += bf_hi(o.w); }
                    u32x4 w; w.x = cvt_pk_bf16(r[0], r[1]); w.y = cvt_pk_bf16(r[2], r[3]); w.z = cvt_pk_bf16(r[4], r[5]); w.w = cvt_pk_bf16(r[6], r[7]);
                    *(u32x4*)(rowp + bj * HALF) = w; } }
            asm volatile("" ::: "memory");
        }
    }
};
__device__ __forceinline__ const void* ldptr(volatile PG8_LAS unsigned* tab, int k) {
    const unsigned lo = __builtin_amdgcn_readfirstlane(tab[2 * k]), hi = __builtin_amdgcn_readfirstlane(tab[2 * k + 1]);
    return (const void*)(const __attribute__((address_space(1))) void*)(((unsigned long long)hi << 32) | lo);
}
template <bool INF32> struct EpiResid {
    static constexpr bool PF = false; static constexpr int NST = 16; static constexpr bool PERM = true; static constexpr int OPK = 0;
    volatile PG8_LAS unsigned* pt; int k_xin, k_xout, k_stats, k_g, k_b, ldc; float alpha;
    __device__ __forceinline__ void operator()(const f32x4 (&acc)[2][2][4][2], const Unit& u, int wr, int wc, int fr, int fq) const {
        const void* __restrict__ Xin = ldptr(pt, k_xin); bf16_t* __restrict__ Xout = (bf16_t*)ldptr(pt, k_xout); const float* __restrict__ stats = (const float*)ldptr(pt, k_stats);
        const float* __restrict__ g = (const float*)ldptr(pt, k_g); const float* __restrict__ b = (const float*)ldptr(pt, k_b);
        const int row0 = u.pm * BM + wr * 64 + fr, col0 = u.pn * BM + wc * 32 + 8 * fq;
        f32x4 gv[2][2], bv[2][2];
#pragma unroll
        for (int bj = 0; bj < 2; ++bj)
#pragma unroll
            for (int n = 0; n < 2; ++n) { gv[bj][n] = *(const f32x4*)(g + col0 + bj * HALF + 4 * n) * alpha; bv[bj][n] = *(const f32x4*)(b + col0 + bj * HALF + 4 * n) * alpha; }
#pragma unroll
        for (int am = 0; am < 4; ++am) {
            const int ai = am >> 1;
            f32x4 x[2][2][2]; float mu[2], rs[2];
#pragma unroll
            for (int mm = 0; mm < 2; ++mm) { const int m = (am & 1) * 2 + mm; const size_t row = (size_t)(row0 + ai * HALF + m * 16);
                const f32x2 st = *(const f32x2*)(stats + 2 * row); mu[mm] = st.x; rs[mm] = st.y;
#pragma unroll
                for (int bj = 0; bj < 2; ++bj) {
                    if constexpr (INF32) { const float* ip = (const float*)Xin + row * ldc + col0 + bj * HALF; x[mm][bj][0] = *(const f32x4*)ip; x[mm][bj][1] = *(const f32x4*)(ip + 4); }
                    else { const u32x4 w = *(const u32x4*)((const bf16_t*)Xin + row * ldc + col0 + bj * HALF);
                           x[mm][bj][0] = (f32x4){bf_lo(w.x), bf_hi(w.x), bf_lo(w.y), bf_hi(w.y)}; x[mm][bj][1] = (f32x4){bf_lo(w.z), bf_hi(w.z), bf_lo(w.w), bf_hi(w.w)}; } } }
#pragma unroll
            for (int mm = 0; mm < 2; ++mm) { const int m = (am & 1) * 2 + mm; const size_t row = (size_t)(row0 + ai * HALF + m * 16); bf16_t* op = Xout + row * ldc + col0;
#pragma unroll
                for (int bj = 0; bj < 2; ++bj) { const f32x4 y0 = (x[mm][bj][0] - mu[mm]) * rs[mm] * gv[bj][0] + bv[bj][0] + acc[ai][bj][m][0], y1 = (x[mm][bj][1] - mu[mm]) * rs[mm] * gv[bj][1] + bv[bj][1] + acc[ai][bj][m][1];
                    u32x4 w; w.x = cvt_pk_bf16(y0[0], y0[1]); w.y = cvt_pk_bf16(y0[2], y0[3]); w.z = cvt_pk_bf16(y1[0], y1[1]); w.w = cvt_pk_bf16(y1[2], y1[3]);
                    *(u32x4*)(op + bj * HALF) = w; } }
            asm volatile("" ::: "memory");
        }
    }
};
struct EpiSwiglu {
    static constexpr bool PF = true; static constexpr int NST = 8; static constexpr bool PERM = true; static constexpr int OPK = 1;
    bf16_t* __restrict__ O; int ldc; const float* __restrict__ sx; const float* __restrict__ swmax;
    __device__ __forceinline__ const float* pf_row(const Unit& u) const { return sx + u.pm * BM; }
    __device__ __forceinline__ const float* pf_col(const Unit& u) const { return swmax + u.pb * BM; }
    __device__ __forceinline__ void operator()(const v4i (&acc)[2][2][4][2], const Unit& u, int wr, int wc, int fr, int fq) const { pf(acc, u, wr, wc, fr, fq, nullptr); }
    __device__ __forceinline__ void pf(const v4i (&acc)[2][2][4][2], const Unit& u, int wr, int wc, int fr, int fq, const PG8_LAS unsigned char* prm) const {
        const int row0 = u.pm * BM + wr * 64 + fr, col0 = u.pn * HALF + wc * 32 + 8 * fq;
        f32x4 cs[2][2];
#pragma unroll
        for (int bj = 0; bj < 2; ++bj)
#pragma unroll
            for (int n = 0; n < 2; ++n) cs[bj][n] = (prm ? *(const PG8_LAS f32x4*)(prm + 1024 + (wc * 32 + 8 * fq + bj * HALF + 4 * n) * 4) : *(const f32x4*)(swmax + u.pb * BM + wc * 32 + 8 * fq + bj * HALF + 4 * n)) * (1.0f / 127.0f);
        float rsv[8];
#pragma unroll
        for (int r8 = 0; r8 < 8; ++r8) rsv[r8] = prm ? *(const PG8_LAS float*)(prm + (wr * 64 + fr + (r8 >> 2) * HALF + (r8 & 3) * 16) * 4) : sx[row0 + (r8 >> 2) * HALF + (r8 & 3) * 16];
#pragma unroll
        for (int ai = 0; ai < 2; ++ai)
#pragma unroll
            for (int m = 0; m < 4; ++m) { const int row = row0 + ai * HALF + m * 16; bf16_t* rowp = O + (size_t)row * ldc + col0;
                const float rs = rsv[ai * 4 + m];
                float r[8];
#pragma unroll
                for (int n = 0; n < 2; ++n) { const f32x4 gv = __builtin_convertvector(acc[ai][0][m][n], f32x4) * cs[0][n] * rs, uv = __builtin_convertvector(acc[ai][1][m][n], f32x4) * cs[1][n] * rs;
#pragma unroll
                    for (int j = 0; j < 4; ++j) r[4 * n + j] = gv[j] * sigmoidf_fast(gv[j]) * uv[j]; }
                u32x4 w; w.x = cvt_pk_bf16(r[0], r[1]); w.y = cvt_pk_bf16(r[2], r[3]); w.z = cvt_pk_bf16(r[4], r[5]); w.w = cvt_pk_bf16(r[6], r[7]);
                *(u32x4*)rowp = w; }
    }
};

__device__ __forceinline__ int opqv(int v) { asm volatile("" : "+v"(v)); return v; }
template <class Epi, class Sched, bool ALIGN_EPI = false, bool SP2 = false>
__device__ __forceinline__ void gemm_phase(PG8_LAS unsigned char* lds, const Gemm g, const Sched& S, const Epi& E) {
    const int tid = opqv(threadIdx.x), wid = __builtin_amdgcn_readfirstlane(tid >> 6), lane = tid & 63, wr = wid >> 2, wc = wid & 3, fr = lane & 15, fq = lane >> 4;
    const int Kb = g.Kb, nt = g.Kx / 128; constexpr int OPK = Epi::OPK; typedef typename AccSel<OPK>::T acc_t;
    unsigned voffA[2], voffB[2];
#pragma unroll
    for (int i = 0; i < 2; ++i) { int R, C; stage_rc(tid * 16 + i * 8192, R, C); const int Rb = Epi::PERM ? ((R & ~31) + perm32(R & 31)) : R;
        voffA[i] = (unsigned)(R * Kb + C * 2); voffB[i] = (unsigned)(Rb * Kb + C * 2); }
    const size_t kstep = (size_t)(BK * 2);
    const size_t hstep = (size_t)HALF * Kb;
    const size_t tstep = 2 * hstep;
    const unsigned ldsw = (unsigned)wid * 1024u;
    const int aoff = lds_byte(wr * 64 + fr, fq * 8), boff = lds_byte(wc * 32 + fr, fq * 8);
#define PG8_SA(b, h) (((b) * 2 + (h)) * HTB)
#define PG8_SB(b, h) ((4 + (b) * 2 + (h)) * HTB)
#define PG8_STAGE(bufoff, gbase, voff) do { _Pragma("unroll") for (int _i = 0; _i < 2; ++_i) \
        __builtin_amdgcn_global_load_lds((const unsigned*)((const char*)(gbase) + (voff)[_i]), (PG8_LAS unsigned*)(lds + (bufoff) + ldsw + _i * 8192), 16, 0, 0); } while (0)
#define PG8_LDA(dst, b, h) do { _Pragma("unroll") for (int m = 0; m < 4; ++m) _Pragma("unroll") for (int k = 0; k < 2; ++k) dst[m][k] = *(const PG8_LAS bf16x8*)(lds + PG8_SA(b, h) + aoff + m * 2048 + k * 1024); } while (0)
#define PG8_LDB(dst, b, h) do { _Pragma("unroll") for (int n = 0; n < 2; ++n) _Pragma("unroll") for (int k = 0; k < 2; ++k) dst[n][k] = *(const PG8_LAS bf16x8*)(lds + PG8_SB(b, h) + boff + n * 2048 + k * 1024); } while (0)
#define PG8_MMA(ai, bj, At, Bt) do { __builtin_amdgcn_s_setprio(1); _Pragma("unroll") for (int m = 0; m < 4; ++m) _Pragma("unroll") for (int n = 0; n < 2; ++n) _Pragma("unroll") for (int k = 0; k < 2; ++k) { \
        if constexpr (OPK == 0) acc[ai][bj][m][n] = __builtin_bit_cast(acc_t, __builtin_amdgcn_mfma_f32_16x16x32_bf16(Bt[n][k], At[m][k], __builtin_bit_cast(f32x4, acc[ai][bj][m][n]), 0, 0, 0)); \
        else acc[ai][bj][m][n] = __builtin_bit_cast(acc_t, __builtin_amdgcn_mfma_i32_16x16x64_i8(__builtin_bit_cast(v4i, Bt[n][k]), __builtin_bit_cast(v4i, At[m][k]), __builtin_bit_cast(v4i, acc[ai][bj][m][n]), 0, 0, 0)); } \
        __builtin_amdgcn_s_setprio(0); } while (0)
#define PG8_WAIT_V(n) asm volatile("s_waitcnt vmcnt(" #n ")" ::: "memory")
#define PG8_WAIT_L(n) asm volatile("s_waitcnt lgkmcnt(" #n ")" ::: "memory")
#define PG8_BAR __builtin_amdgcn_s_barrier()
#define PG8_SCHED __builtin_amdgcn_sched_barrier(0)
    Unit cur, nxt; int ui = 0;
    if (!S.next(0, cur)) return;
    constexpr int PF_OFF = 139584;
#define PG8_PF_ISSUE(U, BUFI) do { if constexpr (Epi::PF) { \
        const float* src_ = (wid < 4 ? E.pf_row(U) + wid * 64 : E.pf_col(U) + (wid - 4) * 64) + lane; \
        __builtin_amdgcn_global_load_lds((const unsigned*)src_, (PG8_LAS unsigned*)(lds + PF_OFF + (BUFI) * 2048 + (wid < 4 ? wid * 256 : 1024 + (wid - 4) * 256)), 4, 0, 0); } } while (0)
    PG8_PF_ISSUE(cur, 0);
    acc_t acc[2][2][4][2];
#pragma unroll
    for (int a = 0; a < 2; ++a)
#pragma unroll
        for (int b = 0; b < 2; ++b)
#pragma unroll
            for (int m = 0; m < 4; ++m)
#pragma unroll
                for (int n = 0; n < 2; ++n) acc[a][b][m][n] = acc_t{};
    bf16x8 At[4][2], B0[2][2], B1[2][2];
    const char* cA = (const char*)g.A + (size_t)cur.pm * tstep + cur.koff; const char* cB = (const char*)g.Bt + (size_t)cur.pb * tstep + cur.koff;
    if constexpr (SP2) {
        PG8_STAGE(PG8_SB(0, 0), cB, voffB); PG8_STAGE(PG8_SB(0, 1), cB + hstep, voffB); PG8_STAGE(PG8_SA(0, 0), cA, voffA); PG8_STAGE(PG8_SA(0, 1), cA + hstep, voffA);
        if (wr == 1) PG8_BAR;
        PG8_WAIT_V(2); PG8_BAR;
        PG8_STAGE(PG8_SB(1, 0), cB + kstep, voffB); PG8_STAGE(PG8_SA(1, 0), cA + kstep, voffA); PG8_STAGE(PG8_SB(1, 1), cB + hstep + kstep, voffB);
        PG8_WAIT_V(6); PG8_BAR;
    } else {
        PG8_STAGE(PG8_SB(0, 0), cB, voffB); PG8_STAGE(PG8_SA(0, 0), cA, voffA); PG8_STAGE(PG8_SB(0, 1), cB + hstep, voffB); PG8_STAGE(PG8_SA(0, 1), cA + hstep, voffA);
        if (wr == 1) PG8_BAR;
        PG8_WAIT_V(4); PG8_BAR;
        PG8_STAGE(PG8_SB(1, 0), cB + kstep, voffB); PG8_STAGE(PG8_SA(1, 0), cA + kstep, voffA); PG8_STAGE(PG8_SB(1, 1), cB + hstep + kstep, voffB);
        PG8_WAIT_V(6); PG8_BAR;
    }
    for (;;) {
        const bool has_next = S.next(ui + 1, nxt);
        const char* nA = has_next ? (const char*)g.A + (size_t)nxt.pm * tstep + nxt.koff : cA; const char* nB = has_next ? (const char*)g.Bt + (size_t)nxt.pb * tstep + nxt.koff : cB;
#define PG8_KITER_SP2(WV) do { \
            PG8_LDB(B0, 0, 0); PG8_LDB(B1, 0, 1); PG8_SCHED; PG8_LDA(At, 0, 0); PG8_STAGE(PG8_SA(1, 1), a1 + hstep, voffA); \
            WV; PG8_WAIT_L(0); PG8_BAR; PG8_MMA(0, 0, At, B0); PG8_MMA(0, 1, At, B1); PG8_BAR; PG8_SCHED; \
            PG8_LDA(At, 0, 1); PG8_STAGE(PG8_SB(0, 0), b2, voffB); PG8_STAGE(PG8_SB(0, 1), b2 + hstep, voffB); PG8_STAGE(PG8_SA(0, 0), a2, voffA); \
            WV; PG8_WAIT_L(0); PG8_BAR; PG8_MMA(1, 0, At, B0); PG8_MMA(1, 1, At, B1); PG8_BAR; PG8_SCHED; \
            PG8_LDB(B0, 1, 0); PG8_LDB(B1, 1, 1); PG8_SCHED; PG8_LDA(At, 1, 0); PG8_STAGE(PG8_SA(0, 1), a2 + hstep, voffA); \
            PG8_WAIT_V(8); PG8_WAIT_L(0); PG8_BAR; PG8_MMA(0, 0, At, B0); PG8_MMA(0, 1, At, B1); PG8_BAR; PG8_SCHED; \
            PG8_LDA(At, 1, 1); PG8_STAGE(PG8_SB(1, 0), b3, voffB); PG8_STAGE(PG8_SB(1, 1), b3 + hstep, voffB); PG8_STAGE(PG8_SA(1, 0), a3, voffA); \
            PG8_WAIT_V(8); PG8_WAIT_L(0); PG8_BAR; PG8_MMA(1, 0, At, B0); PG8_MMA(1, 1, At, B1); PG8_BAR; PG8_SCHED; } while (0)
#define PG8_WV_SP2 asm volatile("s_cmp_eq_u32 %0, 0\n\ts_cbranch_scc1 .Lwv8_%=\n\ts_waitcnt vmcnt(%1)\n\ts_branch .Lwvx_%=\n.Lwv8_%=:\n\ts_waitcnt vmcnt(8)\n.Lwvx_%=:" :: "s"(rlx), "n"(8 + Epi::NST) : "memory", "scc")
        for (int t = 0; t < nt; t += 2) {
            const bool last = (t == nt - 2); const int rlx = __builtin_amdgcn_readfirstlane((SP2 && Epi::NST > 0 && ui > 0 && t == 0 && nt > 2) ? 1 : 0); (void)rlx;
            const char* a1 = cA + (size_t)(t + 1) * kstep;
            const char* a2 = last ? nA : cA + (size_t)(t + 2) * kstep; const char* b2 = last ? nB : cB + (size_t)(t + 2) * kstep;
            const char* a3 = a2 + kstep; const char* b3 = b2 + kstep;
            if constexpr (SP2) {
            PG8_KITER_SP2(PG8_WV_SP2);
            } else {
            PG8_LDB(B0, 0, 0); PG8_SCHED; PG8_LDA(At, 0, 0); PG8_STAGE(PG8_SA(1, 1), a1 + hstep, voffA);
            PG8_WAIT_L(8); PG8_BAR; PG8_WAIT_L(0); PG8_MMA(0, 0, At, B0); PG8_BAR; PG8_SCHED;
            PG8_LDB(B1, 0, 1); PG8_STAGE(PG8_SB(0, 0), b2, voffB);
            PG8_BAR; PG8_WAIT_L(0); PG8_MMA(0, 1, At, B1); PG8_BAR;
            PG8_LDA(At, 0, 1); PG8_STAGE(PG8_SA(0, 0), a2, voffA);
            PG8_BAR; PG8_WAIT_L(0); PG8_MMA(1, 0, At, B0); PG8_BAR; PG8_SCHED;
            PG8_STAGE(PG8_SB(0, 1), b2 + hstep, voffB);
            PG8_WAIT_V(6); PG8_BAR; PG8_MMA(1, 1, At, B1); PG8_BAR;
            PG8_LDB(B0, 1, 0); PG8_SCHED; PG8_LDA(At, 1, 0); PG8_STAGE(PG8_SA(0, 1), a2 + hstep, voffA);
            PG8_WAIT_L(8); PG8_BAR; PG8_WAIT_L(0); PG8_MMA(0, 0, At, B0); PG8_BAR; PG8_SCHED;
            PG8_LDB(B1, 1, 1); PG8_STAGE(PG8_SB(1, 0), b3, voffB);
            PG8_BAR; PG8_WAIT_L(0); PG8_MMA(0, 1, At, B1); PG8_BAR;
            PG8_LDA(At, 1, 1); PG8_STAGE(PG8_SA(1, 0), a3, voffA);
            PG8_BAR; PG8_WAIT_L(0); PG8_MMA(1, 0, At, B0); PG8_BAR; PG8_SCHED;
            PG8_STAGE(PG8_SB(1, 1), b3 + hstep, voffB);
            PG8_WAIT_V(6); PG8_BAR; PG8_MMA(1, 1, At, B1); PG8_BAR;
            }
        }
        if constexpr (ALIGN_EPI) { if (wr == 0) PG8_BAR; }
        if constexpr (Epi::PF) E.pf(acc, cur, wr, wc, fr, fq, lds + PF_OFF + (ui & 1) * 2048); else E(acc, cur, wr, wc, fr, fq);
        if (!has_next) break;
        PG8_PF_ISSUE(nxt, (ui + 1) & 1);
#pragma unroll
        for (int a = 0; a < 2; ++a)
#pragma unroll
            for (int b = 0; b < 2; ++b)
#pragma unroll
                for (int m = 0; m < 4; ++m)
#pragma unroll
                    for (int n = 0; n < 2; ++n) acc[a][b][m][n] = acc_t{};
        cur = nxt; cA = nA; cB = nB; ++ui;
        if constexpr (ALIGN_EPI) { if (wr == 1) PG8_BAR; }
    }
    PG8_WAIT_V(0);
    if constexpr (!ALIGN_EPI) { if (wr == 0) PG8_BAR; }
    PG8_BAR;
#undef PG8_KITER_SP2
#undef PG8_PF_ISSUE
#undef PG8_WV_SP2
#undef PG8_SA
#undef PG8_SB
#undef PG8_STAGE
#undef PG8_LDA
#undef PG8_LDB
#undef PG8_MMA
#undef PG8_WAIT_V
#undef PG8_WAIT_L
#undef PG8_BAR
#undef PG8_SCHED
}
}
constexpr int NWAVES = 8;
constexpr int BATCH = 4, SEQ = 4096, DM = 2048, MTOK = BATCH * SEQ;
constexpr int HD = 128, NHA = 8, NIH = 16, IDXD = 64, CHUNK = 64, TOPK = 256;
constexpr int DFF = 5632, NEXP = 8, DEXP = 7168;
constexpr int INCOLS = 11344, LDH = 11520;
constexpr int C_QA = 0, C_KA = 1024, C_VA = 2048, C_QI = 3072, C_QB = 4096, C_KB = 5120, C_VB = 6144, C_GA = 7168, C_GB = 9216, C_KI = 11264, C_WI = 11328;
constexpr float LN_EPS = 1e-5f;
constexpr float DN_ALPHA = 1.4142135623730951f;
constexpr int MAXSLOT = 2 * MTOK + NEXP * 256;

#define GAS __attribute__((address_space(1)))
#define LAS __attribute__((address_space(3)))
typedef unsigned short bf16;
typedef unsigned v4u __attribute__((ext_vector_type(4)));
typedef unsigned v2u __attribute__((ext_vector_type(2)));
typedef float f32x4 __attribute__((ext_vector_type(4)));
typedef float f32x16 __attribute__((ext_vector_type(16)));
typedef float f32x2v __attribute__((ext_vector_type(2)));
typedef short bf16x8 __attribute__((ext_vector_type(8)));
typedef short s16x4 __attribute__((ext_vector_type(4)));
typedef GAS unsigned gu32;
#define RLX_AGENT __ATOMIC_RELAXED, __HIP_MEMORY_SCOPE_AGENT
#define LDS_WAIT() do { __builtin_amdgcn_s_waitcnt(0xC07F); asm volatile("" ::: "memory"); } while (0)
#define VM_WAIT() do { __builtin_amdgcn_s_waitcnt(0x0F70); asm volatile("" ::: "memory"); } while (0)
#define SBAR() __builtin_amdgcn_sched_barrier(0)
__device__ __forceinline__ unsigned f2bf(float f) { unsigned u = __builtin_bit_cast(unsigned, f); return (u + 0x7fffu + ((u >> 16) & 1u)) >> 16; }
__device__ __forceinline__ unsigned pk2(float lo, float hi) { return f2bf(lo) | (f2bf(hi) << 16); }
__device__ __forceinline__ float bflo(unsigned w) { return __uint_as_float(w << 16); }
__device__ __forceinline__ float bfhi(unsigned w) { return __uint_as_float(w & 0xffff0000u); }
__device__ __forceinline__ unsigned cvtpk(float lo, float hi) { unsigned r; asm volatile("v_cvt_pk_bf16_f32 %0, %1, %2" : "=v"(r) : "v"(lo), "v"(hi)); return r; }

namespace att {
constexpr int SHM_V = 64 * 128 * 2, SHM_K = 64 * 128 * 2;
constexpr int OFF_V = 0, OFF_K = 2 * SHM_V, OFF_SCR = 2 * SHM_V + 2 * SHM_K, OFF_FLAG = OFF_SCR + NWAVES * 64 * 4;
#define KSWZ(row, colB) ((row) * 256 + ((colB) ^ (((row) & 7) << 4)))
__device__ __forceinline__ int v_st(int k, int c) { const int kk = (k & ~0xC) | ((k & 4) << 1) | ((k & 8) >> 1); return ((kk >> 3) * 4 + (c >> 5)) * 512 + ((kk & 7) * 32 + (c & 31)) * 2; }
__device__ __forceinline__ int v_rd_base(int lane) { return ((lane & 3) << 3) | (((lane >> 2) & 3) << 6) | (((lane >> 4) & 1) << 5) | (((lane >> 5) & 1) << 8); }
constexpr int v_rd_off(int d0, int ks, int half) { return d0 * 512 + ks * 4096 + half * 2048; }
__device__ __forceinline__ int crow(int r, int hi) { return (r & 3) + 8 * (r >> 2) + 4 * hi; }

template <int KB>
__device__ __forceinline__ void qkt(f32x16& p0, f32x16& p1, LAS unsigned char* K_lds, int r32, int hi, const bf16x8* qr) {
    p0 = f32x16{}; p1 = f32x16{};
    const LAS unsigned char* kb[4];
#pragma unroll
    for (int dd = 0; dd < 4; ++dd) kb[dd] = K_lds + KB * SHM_K + KSWZ(r32, (dd * 16 + hi * 8) * 2);
#pragma unroll
    for (int d0 = 0; d0 < 8; ++d0) { const LAS unsigned char* a = kb[d0 & 3] + (d0 >> 2) * 128;
        bf16x8 b0 = *(const LAS bf16x8*)(a);
        bf16x8 b1 = *(const LAS bf16x8*)(a + 32 * 256);
        p0 = __builtin_amdgcn_mfma_f32_32x32x16_bf16(b0, qr[d0], p0, 0, 0, 0);
        p1 = __builtin_amdgcn_mfma_f32_32x32x16_bf16(b1, qr[d0], p1, 0, 0, 0); }
}
template <int VB>
__device__ __forceinline__ void pv_tile(f32x16* o, int vb0, bf16x8 pa0, bf16x8 pa1, bf16x8 pa2, bf16x8 pa3) {
#define TRRD(dst, off) asm volatile("ds_read_b64_tr_b16 %0, %1 offset:%2" : "=&v"(dst) : "v"(vb0), "i"(off) : "memory")
#define PV_D0(d0) do { s16x4 l0, l1, l2, l3, h0, h1, h2, h3; constexpr int b_ = VB * SHM_V + v_rd_off(d0, 0, 0); \
        TRRD(l0, b_); TRRD(h0, b_ + 2048); TRRD(l1, b_ + 4096); TRRD(h1, b_ + 6144); TRRD(l2, b_ + 8192); TRRD(h2, b_ + 10240); TRRD(l3, b_ + 12288); TRRD(h3, b_ + 14336); \
        LDS_WAIT(); SBAR(); \
        o[d0] = __builtin_amdgcn_mfma_f32_32x32x16_bf16(pa0, (bf16x8){l0[0], l0[1], l0[2], l0[3], h0[0], h0[1], h0[2], h0[3]}, o[d0], 0, 0, 0);   \
        o[d0] = __builtin_amdgcn_mfma_f32_32x32x16_bf16(pa1, (bf16x8){l1[0], l1[1], l1[2], l1[3], h1[0], h1[1], h1[2], h1[3]}, o[d0], 0, 0, 0);   \
        o[d0] = __builtin_amdgcn_mfma_f32_32x32x16_bf16(pa2, (bf16x8){l2[0], l2[1], l2[2], l2[3], h2[0], h2[1], h2[2], h2[3]}, o[d0], 0, 0, 0);   \
        o[d0] = __builtin_amdgcn_mfma_f32_32x32x16_bf16(pa3, (bf16x8){l3[0], l3[1], l3[2], l3[3], h3[0], h3[1], h3[2], h3[3]}, o[d0], 0, 0, 0); } while (0)
    PV_D0(0); PV_D0(1); PV_D0(2); PV_D0(3);
#undef PV_D0
#undef TRRD
}
__device__ __forceinline__ void pack_p(const f32x16& p0, const f32x16& p1, bf16x8& pa0, bf16x8& pa1, bf16x8& pa2, bf16x8& pa3) {
#define PK4(P, B_, OUT) do { unsigned a0 = cvtpk(P[B_+0], P[B_+1]), a1 = cvtpk(P[B_+2], P[B_+3]);                          \
        unsigned b0 = cvtpk(P[B_+4], P[B_+5]), b1 = cvtpk(P[B_+6], P[B_+7]);                                             \
        auto r0 = __builtin_amdgcn_permlane32_swap(a0, b0, false, false); auto r1 = __builtin_amdgcn_permlane32_swap(a1, b1, false, false); \
        v4u w = {r0[0], r1[0], r0[1], r1[1]}; OUT = __builtin_bit_cast(bf16x8, w); } while (0)
    PK4(p0, 0, pa0); PK4(p0, 8, pa1); PK4(p1, 0, pa2); PK4(p1, 8, pa3);
#undef PK4
}
__device__ __forceinline__ float xhalf_max(float v) { auto rr = __builtin_amdgcn_permlane32_swap(__float_as_uint(v), __float_as_uint(v), false, false); return fmaxf(__uint_as_float(rr[0]), __uint_as_float(rr[1])); }
__device__ __forceinline__ float xhalf_sum(float v) { auto rr = __builtin_amdgcn_permlane32_swap(__float_as_uint(v), __float_as_uint(v), false, false); return __uint_as_float(rr[0]) + __uint_as_float(rr[1]); }
__device__ __forceinline__ float xhalf_other(float v, int hi) { auto rr = __builtin_amdgcn_permlane32_swap(__float_as_uint(v), __float_as_uint(v), false, false); return __uint_as_float(hi ? rr[0] : rr[1]); }

struct St {
    f32x16 o[4]; float m_reg, l_reg, Lrun;
};

template <int MODE, int KB>
__device__ __forceinline__ void tile_step(St& S, LAS unsigned char* lds, int vb0, const bf16x8* qr, int r32, int hi, int wid, unsigned long long mw, int kt, int trow, bool act) {
    if (!act) return;
    f32x16 p0, p1;
    qkt<KB>(p0, p1, lds + OFF_K, r32, hi, qr);
    LAS float* scr = (LAS float*)(lds + OFF_SCR) + wid * 64; LAS float* al_l = scr + 32;
    bf16x8 pa0, pa1, pa2, pa3;
    if (MODE == 0) {
        constexpr float C2 = 1.4426950408889634f * 0.08838834764831845f;
        const float NEG = -__builtin_inff();
        const unsigned mlo = (unsigned)mw, mhi = (unsigned)(mw >> 32);
#pragma unroll
        for (int r = 0; r < 16; ++r) { const int c = (r & 3) + 8 * (r >> 2) + 4 * hi;
            if (!((mlo >> c) & 1u)) p0[r] = NEG;
            if (!((mhi >> c) & 1u)) p1[r] = NEG; }
        float pmax = p0[0];
#pragma unroll
        for (int r = 1; r < 16; ++r) pmax = fmaxf(pmax, p0[r]);
#pragma unroll
        for (int r = 0; r < 16; ++r) pmax = fmaxf(pmax, p1[r]);
        pmax = xhalf_max(pmax);
        const float mn = fmaxf(S.m_reg, pmax);
        const float alpha = __builtin_amdgcn_exp2f((S.m_reg - mn) * C2);
        S.m_reg = mn;
        const float mnL = -mn * C2;
        float ps = 0.f;
#pragma unroll
        for (int r = 0; r < 16; ++r) { p0[r] = __builtin_amdgcn_exp2f(fmaf(p0[r], C2, mnL)); p1[r] = __builtin_amdgcn_exp2f(fmaf(p1[r], C2, mnL)); ps += p0[r] + p1[r]; }
        ps = xhalf_sum(ps);
        S.l_reg = S.l_reg * alpha + ps;
        if (__any(alpha < 1.f)) {
            if (hi == 0) al_l[r32] = alpha;
            LDS_WAIT();
#pragma unroll
            for (int r = 0; r < 16; ++r) { const float a = al_l[crow(r, hi)];
#pragma unroll
                for (int d = 0; d < 4; ++d) S.o[d][r] *= a; }
        }
        pack_p(p0, p1, pa0, pa1, pa2, pa3);
    } else {
        constexpr float C2 = 1.4426950408889634f * 0.08838834764831845f;
        const int kbase = kt * 64 + 4 * hi;
        const bool needmask = (kt * 64 + 63 >= trow - r32);
        float lk0[16], lk1[16];
#pragma unroll
        for (int r = 0; r < 16; ++r) {
            const int key0 = kbase + (r & 3) + 8 * (r >> 2);
            { const float z2 = p0[r] * C2; const float sp = fmaxf(z2, 0.f) + __builtin_amdgcn_logf(1.0f + __builtin_amdgcn_exp2f(-fabsf(z2)));
              const bool msk = needmask && (key0 >= trow); lk0[r] = msk ? 0.f : -sp; p0[r] = msk ? -__builtin_inff() : (z2 - sp); }
            { const float z2 = p1[r] * C2; const float sp = fmaxf(z2, 0.f) + __builtin_amdgcn_logf(1.0f + __builtin_amdgcn_exp2f(-fabsf(z2)));
              const bool msk = needmask && (key0 + 32 >= trow); lk1[r] = msk ? 0.f : -sp; p1[r] = msk ? -__builtin_inff() : (z2 - sp); }
        }
        float So[8], Sp[8], W[8];
#pragma unroll
        for (int g = 0; g < 4; ++g) { So[g] = (lk0[4 * g] + lk0[4 * g + 1]) + (lk0[4 * g + 2] + lk0[4 * g + 3]); So[4 + g] = (lk1[4 * g] + lk1[4 * g + 1]) + (lk1[4 * g + 2] + lk1[4 * g + 3]); }
#pragma unroll
        for (int g = 0; g < 8; ++g) Sp[g] = xhalf_other(So[g], hi);
        float run = S.Lrun;
#pragma unroll
        for (int g = 7; g >= 0; --g) { W[g] = run + (hi == 0 ? Sp[g] : 0.f); run += So[g] + Sp[g]; }
        S.Lrun = run;
#pragma unroll
        for (int g = 0; g < 4; ++g) {
            { float e = W[g];     p0[4 * g + 3] = __builtin_amdgcn_exp2f(p0[4 * g + 3] + e); e += lk0[4 * g + 3]; p0[4 * g + 2] = __builtin_amdgcn_exp2f(p0[4 * g + 2] + e); e += lk0[4 * g + 2];
                                  p0[4 * g + 1] = __builtin_amdgcn_exp2f(p0[4 * g + 1] + e); e += lk0[4 * g + 1]; p0[4 * g]     = __builtin_amdgcn_exp2f(p0[4 * g] + e); }
            { float e = W[4 + g]; p1[4 * g + 3] = __builtin_amdgcn_exp2f(p1[4 * g + 3] + e); e += lk1[4 * g + 3]; p1[4 * g + 2] = __builtin_amdgcn_exp2f(p1[4 * g + 2] + e); e += lk1[4 * g + 2];
                                  p1[4 * g + 1] = __builtin_amdgcn_exp2f(p1[4 * g + 1] + e); e += lk1[4 * g + 1]; p1[4 * g]     = __builtin_amdgcn_exp2f(p1[4 * g] + e); }
        }
        pack_p(p0, p1, pa0, pa1, pa2, pa3);
    }
    pv_tile<KB>(S.o, vb0, pa0, pa1, pa2, pa3);
}

template <int MODE>
__device__ __forceinline__ void attn_unit(LAS unsigned char* lds, const bf16* __restrict__ H, const unsigned long long* __restrict__ mask, unsigned char* __restrict__ O, float oinv, int b, int h, int qb) {
    const int tid = pg8::opqv(threadIdx.x), wid = __builtin_amdgcn_readfirstlane(tid >> 6), lane = tid & 63, r32 = lane & 31, hi = lane >> 5;
    const int cq = (MODE == 0 ? C_QA : C_QB) + h * HD, ck = (MODE == 0 ? C_KA : C_KB) + h * HD, cv = (MODE == 0 ? C_VA : C_VB) + h * HD;
    const int trow = qb * 256 + wid * 32 + r32;
    const size_t grow = (size_t)b * SEQ + trow;
    bf16x8 qr[8];
#pragma unroll
    for (int d0 = 0; d0 < 8; ++d0) qr[d0] = *(const bf16x8*)(H + grow * LDH + cq + d0 * 16 + hi * 8);
    const int NT = 4 * qb + 4;
    const int sr = tid >> 4, sc = (tid & 15) * 8;
    const int vst0 = v_st(sr, sc), vst1 = v_st(32 + sr, sc), kws = KSWZ(sr, sc * 2);
    LAS unsigned char* V_lds = lds + OFF_V; LAS unsigned char* K_lds = lds + OFF_K;
    const int vb0 = (int)(unsigned)(size_t)(V_lds) + v_rd_base(lane);
    volatile LAS unsigned* flags = (volatile LAS unsigned*)(lds + OFF_FLAG);
    const bf16* Kg = H + (size_t)b * SEQ * LDH + ck + sc; const bf16* Vg = H + (size_t)b * SEQ * LDH + cv + sc;
    St S;
#pragma unroll
    for (int d = 0; d < 4; ++d) S.o[d] = f32x16{};
    S.m_reg = -1e30f; S.l_reg = 0.f; S.Lrun = 0.f;
    bf16x8 st_k0, st_k1, st_v0, st_v1;
#define KT_OF(t) (MODE == 0 ? (t) : (NT - 1 - (t)))
#define SLOAD(t) do { const size_t k0_ = (size_t)KT_OF(t) * 64; st_k0 = *(const bf16x8*)(Kg + (k0_ + sr) * LDH); st_k1 = *(const bf16x8*)(Kg + (k0_ + 32 + sr) * LDH); \
                      st_v0 = *(const bf16x8*)(Vg + (k0_ + sr) * LDH); st_v1 = *(const bf16x8*)(Vg + (k0_ + 32 + sr) * LDH); } while (0)
#define SWRITE(bf) do { *(LAS bf16x8*)(K_lds + (bf) * SHM_K + kws) = st_k0; *(LAS bf16x8*)(K_lds + (bf) * SHM_K + kws + 32 * 256) = st_k1; \
                        *(LAS bf16x8*)(V_lds + (bf) * SHM_V + vst0) = st_v0; *(LAS bf16x8*)(V_lds + (bf) * SHM_V + vst1) = st_v1; } while (0)
    SLOAD(0); VM_WAIT(); SWRITE(0); LDS_WAIT(); __syncthreads();
    const int wave_chunk = 4 * qb + (wid >> 1);
    const int tfirst = qb * 256 + wid * 32;
    int t = 0; unsigned long long mwn = 0ull; if (MODE == 0) mwn = mask[grow * 64];
#define STEP(KB, SB) do { \
        const int kt = KT_OF(t); \
        if (t + 1 < NT) SLOAD(t + 1); \
        bool act; unsigned long long mw = mwn; \
        if (MODE == 0) { act = (kt <= wave_chunk); if (t + 1 < NT && t + 1 <= wave_chunk) mwn = mask[grow * 64 + t + 1]; } \
        else { act = (kt * 64 < tfirst + 31) && !__all(S.Lrun < -136.f); } \
        tile_step<MODE, KB>(S, lds, vb0, qr, r32, hi, wid, mw, kt, trow, act); \
        if (t + 1 < NT) { VM_WAIT(); SWRITE(SB); } \
        if (MODE == 1) { const bool dn = __all(S.Lrun < -136.f); if (lane == 0) flags[(t & 1) * 8 + wid] = dn ? 1u : 0u; } \
        LDS_WAIT(); __syncthreads(); \
        if (MODE == 1) { unsigned all = 1u; _Pragma("unroll") for (int w_ = 0; w_ < 8; ++w_) all &= flags[(t & 1) * 8 + w_]; if (all) { t = NT; } } \
        ++t; } while (0)
    for (;;) {
        STEP(0, 1); if (t >= NT) break;
        STEP(1, 0); if (t >= NT) break;
    }
#undef STEP
#undef SLOAD
#undef SWRITE
#undef KT_OF
    LAS float* scr = (LAS float*)(lds + OFF_SCR) + wid * 64;
    float rli[16];
    if (MODE == 0) {
        if (hi == 0) scr[r32] = S.l_reg;
        LDS_WAIT();
#pragma unroll
        for (int r = 0; r < 16; ++r) rli[r] = __builtin_amdgcn_rcpf(scr[crow(r, hi)]);
    }
    unsigned char* Ow = O + ((size_t)b * SEQ + qb * 256 + wid * 32) * 1024 + h * HD;
#pragma unroll
    for (int r = 0; r < 16; ++r) { const int orow = crow(r, hi);
#pragma unroll
        for (int d0 = 0; d0 < 4; ++d0) { const float v = (MODE == 0 ? S.o[d0][r] * rli[r] : S.o[d0][r]) * oinv;
            int q = __float2int_rn(fminf(fmaxf(v, -127.f), 127.f)) & 0xff;
            const int q1 = __builtin_amdgcn_update_dpp(0, q, 0x55, 0xF, 0xF, true), q2 = __builtin_amdgcn_update_dpp(0, q, 0xAA, 0xF, 0xF, true), q3 = __builtin_amdgcn_update_dpp(0, q, 0xFF, 0xF, 0xF, true);
            if ((r32 & 3) == 0) *(unsigned*)(Ow + (size_t)orow * 1024 + d0 * 32 + r32) = (unsigned)q | ((unsigned)q1 << 8) | ((unsigned)q2 << 16) | ((unsigned)q3 << 24); } }
    LDS_WAIT(); __syncthreads();
}
__device__ __forceinline__ void sm_tile(St& S, f32x16& p0, f32x16& p1, unsigned long long mw, LAS float* al_l, int r32, int hi, bf16x8& pa0, bf16x8& pa1, bf16x8& pa2, bf16x8& pa3) {
    constexpr float C2 = 1.4426950408889634f * 0.08838834764831845f;
    const float NEG = -__builtin_inff();
    const unsigned mlo = (unsigned)mw, mhi = (unsigned)(mw >> 32);
#pragma unroll
    for (int r = 0; r < 16; ++r) { const int c = (r & 3) + 8 * (r >> 2) + 4 * hi;
        if (!((mlo >> c) & 1u)) p0[r] = NEG;
        if (!((mhi >> c) & 1u)) p1[r] = NEG; }
    float pmax = p0[0];
#pragma unroll
    for (int r = 1; r < 16; ++r) pmax = fmaxf(pmax, p0[r]);
#pragma unroll
    for (int r = 0; r < 16; ++r) pmax = fmaxf(pmax, p1[r]);
    pmax = xhalf_max(pmax);
    const float mn = fmaxf(S.m_reg, pmax);
    const float alpha = __builtin_amdgcn_exp2f((S.m_reg - mn) * C2);
    S.m_reg = mn;
    const float mnL = -mn * C2;
    float ps = 0.f;
#pragma unroll
    for (int r = 0; r < 16; ++r) { p0[r] = __builtin_amdgcn_exp2f(fmaf(p0[r], C2, mnL)); p1[r] = __builtin_amdgcn_exp2f(fmaf(p1[r], C2, mnL)); ps += p0[r] + p1[r]; }
    ps = xhalf_sum(ps);
    S.l_reg = S.l_reg * alpha + ps;
    if (__any(alpha < 1.f)) {
        if (hi == 0) al_l[r32] = alpha;
        LDS_WAIT();
#pragma unroll
        for (int r = 0; r < 16; ++r) { const float a = al_l[crow(r, hi)];
#pragma unroll
            for (int d = 0; d < 4; ++d) S.o[d][r] *= a; }
    }
    pack_p(p0, p1, pa0, pa1, pa2, pa3);
}
constexpr float SP_SCALE = 0.08838834764831845f, SP_THR = 8.f;
__device__ __forceinline__ void sp_partialSM(f32x16& p0, f32x16& p1, float& m_reg, float& mn, float& alpha) {
    float pmax = p0[0];
#pragma unroll
    for (int r = 1; r < 16; ++r) pmax = fmaxf(pmax, p0[r]);
#pragma unroll
    for (int r = 0; r < 16; ++r) pmax = fmaxf(pmax, p1[r]);
    pmax = xhalf_max(pmax);
    constexpr float C2 = 1.4426950408889634f * SP_SCALE;
    if (__builtin_expect(__all((pmax - m_reg) * SP_SCALE <= SP_THR), 1)) { mn = m_reg; alpha = 1.f; }
    else { mn = fmaxf(m_reg, pmax); alpha = __builtin_amdgcn_exp2f((m_reg - mn) * C2); m_reg = mn; }
    const float mnL = -mn * C2;
#pragma unroll
    for (int r = 0; r < 16; ++r) { p0[r] = fmaf(p0[r], C2, mnL); p1[r] = fmaf(p1[r], C2, mnL); }
#pragma unroll
    for (int r = 0; r < 16; ++r) p0[r] = __builtin_amdgcn_exp2f(p0[r]);
}
__device__ __forceinline__ void sp_finishSM(f32x16& p0, f32x16& p1, float alpha, float& l_reg, bf16x8& pa0, bf16x8& pa1, bf16x8& pa2, bf16x8& pa3) {
#pragma unroll
    for (int r = 0; r < 16; ++r) p1[r] = __builtin_amdgcn_exp2f(p1[r]);
    float ps = 0.f;
#pragma unroll
    for (int r = 0; r < 16; ++r) ps += p0[r];
#pragma unroll
    for (int r = 0; r < 16; ++r) ps += p1[r];
    ps = xhalf_sum(ps);
    l_reg = l_reg * alpha + ps;
    pack_p(p0, p1, pa0, pa1, pa2, pa3);
}
__device__ __forceinline__ void sp_mask(f32x16& p0, f32x16& p1, unsigned long long mw, int hi) {
    const float NEG = -__builtin_inff();
    const unsigned mlo = (unsigned)mw >> (4 * hi), mhi = (unsigned)(mw >> 32) >> (4 * hi);
#pragma unroll
    for (int r = 0; r < 16; ++r) { const unsigned bit = 1u << ((r & 3) + 8 * (r >> 2));
        if (!(mlo & bit)) p0[r] = NEG;
        if (!(mhi & bit)) p1[r] = NEG; }
}
__device__ __forceinline__ void sparse_unit_p(LAS unsigned char* lds, const bf16* __restrict__ H, const unsigned long long* __restrict__ mask, unsigned char* __restrict__ O, float oinv, int b, int h, int qb) {
    const int tid = pg8::opqv(threadIdx.x), wid = __builtin_amdgcn_readfirstlane(tid >> 6), lane = tid & 63, r32 = lane & 31, hi = lane >> 5;
    const int cq = C_QA + h * HD, ck = C_KA + h * HD, cv = C_VA + h * HD;
    const int trow = qb * 256 + wid * 32 + r32;
    const size_t grow = (size_t)b * SEQ + trow;
    bf16x8 qr[8];
#pragma unroll
    for (int d0 = 0; d0 < 8; ++d0) qr[d0] = *(const bf16x8*)(H + grow * LDH + cq + d0 * 16 + hi * 8);
    const int NT = 4 * qb + 4;
    const int sr = tid >> 4, sc = (tid & 15) * 8;
    const int vst0 = v_st(sr, sc), vst1 = v_st(32 + sr, sc), kws = KSWZ(sr, sc * 2);
    LAS unsigned char* V_lds = lds + OFF_V; LAS unsigned char* K_lds = lds + OFF_K;
    const int vb0 = (int)(unsigned)(size_t)(V_lds) + v_rd_base(lane);
    LAS float* scr = (LAS float*)(lds + OFF_SCR) + wid * 64; LAS float* li_l = scr; LAS float* al_l = scr + 32;
    const bf16* Kg = H + (size_t)b * SEQ * LDH + ck + sc; const bf16* Vg = H + (size_t)b * SEQ * LDH + cv + sc;
    const unsigned long long* mrow = mask + grow * 64;
    float m_reg = -1e30f, l_reg = 0.f; f32x16 o[4];
#pragma unroll
    for (int d = 0; d < 4; ++d) o[d] = f32x16{};
    bf16x8 st_k0, st_k1, st_v0, st_v1;
#define SLOADP(t) do { const size_t k0_ = (size_t)(t) * 64; st_v0 = *(const bf16x8*)(Vg + (k0_ + sr) * LDH); st_v1 = *(const bf16x8*)(Vg + (k0_ + 32 + sr) * LDH); \
                       st_k0 = *(const bf16x8*)(Kg + (k0_ + sr) * LDH); st_k1 = *(const bf16x8*)(Kg + (k0_ + 32 + sr) * LDH); } while (0)
#define SWRITEP(bf) do { *(LAS bf16x8*)(V_lds + (bf) * SHM_V + vst0) = st_v0; *(LAS bf16x8*)(V_lds + (bf) * SHM_V + vst1) = st_v1; \
                         *(LAS bf16x8*)(K_lds + (bf) * SHM_K + kws) = st_k0; *(LAS bf16x8*)(K_lds + (bf) * SHM_K + kws + 32 * 256) = st_k1; } while (0)
#define RESCP(a) do { if (__any((a) < 1.f)) { if (hi == 0) al_l[r32] = (a); LDS_WAIT(); \
        _Pragma("unroll") for (int d_ = 0; d_ < 4; ++d_) _Pragma("unroll") for (int r = 0; r < 16; ++r) o[d_][r] *= al_l[crow(r, hi)]; } } while (0)
    f32x16 pA0, pA1, pB0, pB1; float mnA, mnB, alA, alB; bf16x8 pa0, pa1, pa2, pa3;
    SLOADP(0); VM_WAIT(); SWRITEP(0); LDS_WAIT(); __syncthreads();
    SLOADP(1);
    unsigned long long mw = mrow[0];
    SBAR(); qkt<0>(pA0, pA1, K_lds, r32, hi, qr);
    sp_mask(pA0, pA1, mw, hi); sp_partialSM(pA0, pA1, m_reg, mnA, alA);
    VM_WAIT(); SWRITEP(1);
    LDS_WAIT(); __syncthreads();
    RESCP(alA);
#define HALF_STEPP(PX0, PX1, mnX, alX, PY0, PY1, alY, t, KB, VB, SB) do { \
        mw = mrow[(t)]; \
        SBAR(); qkt<KB>(PX0, PX1, K_lds, r32, hi, qr); \
        sp_finishSM(PY0, PY1, alY, l_reg, pa0, pa1, pa2, pa3); SBAR(); \
        if ((t) + 1 < NT) { SLOADP((t) + 1); SBAR(); } \
        pv_tile<VB>(o, vb0, pa0, pa1, pa2, pa3); sp_mask(PX0, PX1, mw, hi); sp_partialSM(PX0, PX1, m_reg, mnX, alX); \
        __syncthreads(); \
        if ((t) + 1 < NT) { VM_WAIT(); SWRITEP(SB); } \
        RESCP(alX); LDS_WAIT(); __syncthreads(); } while (0)
    for (int t = 1; t + 1 < NT; t += 2) {
        HALF_STEPP(pB0, pB1, mnB, alB, pA0, pA1, alA, t, 1, 0, 0);
        HALF_STEPP(pA0, pA1, mnA, alA, pB0, pB1, alB, t + 1, 0, 1, 1);
    }
    mw = mrow[NT - 1];
    SBAR(); qkt<1>(pB0, pB1, K_lds, r32, hi, qr); SBAR();
    sp_finishSM(pA0, pA1, alA, l_reg, pa0, pa1, pa2, pa3); SBAR();
    pv_tile<0>(o, vb0, pa0, pa1, pa2, pa3);
    sp_mask(pB0, pB1, mw, hi); sp_partialSM(pB0, pB1, m_reg, mnB, alB);
    RESCP(alB);
    sp_finishSM(pB0, pB1, alB, l_reg, pa0, pa1, pa2, pa3); SBAR();
    pv_tile<1>(o, vb0, pa0, pa1, pa2, pa3);
#undef HALF_STEPP
#undef RESCP
#undef SLOADP
#undef SWRITEP
    float rli[16];
    if (hi == 0) li_l[r32] = l_reg;
    LDS_WAIT();
#pragma unroll
    for (int r = 0; r < 16; ++r) rli[r] = __builtin_amdgcn_rcpf(li_l[crow(r, hi)]);
    unsigned char* Ow = O + ((size_t)b * SEQ + qb * 256 + wid * 32) * 1024 + h * HD;
#pragma unroll
    for (int r = 0; r < 16; ++r) { const int orow = crow(r, hi);
#pragma unroll
        for (int d0 = 0; d0 < 4; ++d0) { const float v = o[d0][r] * rli[r] * oinv;
            int q = __float2int_rn(fminf(fmaxf(v, -127.f), 127.f)) & 0xff;
            const int q1 = __builtin_amdgcn_update_dpp(0, q, 0x55, 0xF, 0xF, true), q2 = __builtin_amdgcn_update_dpp(0, q, 0xAA, 0xF, 0xF, true), q3 = __builtin_amdgcn_update_dpp(0, q, 0xFF, 0xF, 0xF, true);
            if ((r32 & 3) == 0) *(unsigned*)(Ow + (size_t)orow * 1024 + d0 * 32 + r32) = (unsigned)q | ((unsigned)q1 << 8) | ((unsigned)q2 << 16) | ((unsigned)q3 << 24); } }
    LDS_WAIT(); __syncthreads();
}
#undef KSWZ
}

__device__ __forceinline__ size_t sc_base(int b, int c) { return (size_t)b * (2048u * 64u * 65u) + (size_t)2048u * c * (c + 1); }
__device__ __forceinline__ void score_task(LAS unsigned char* lds, const bf16* __restrict__ H, float* __restrict__ SC, int b, int c, int h2, int wave, int tid_) {
    const int tid = pg8::opqv(tid_), lane = tid & 63;
    const int r32 = lane & 31, hi = lane >> 5;
    const int ql0 = 32 * h2 + 4 * wave, nk = 64 * (c + 1);
    bf16x8 A[2][4]; float w[2][16]; float* srow[2];
#pragma unroll
    for (int rb = 0; rb < 2; ++rb) {
        const int m = r32, q = (m >> 2) & 1, hh = (m & 3) + 4 * (m >> 3);
        const bf16* qp = H + ((size_t)b * SEQ + CHUNK * c + ql0 + 2 * rb + q) * LDH + C_QI + hh * IDXD + hi * 8;
#pragma unroll
        for (int ks = 0; ks < 4; ++ks) A[rb][ks] = *(const bf16x8*)(qp + ks * 16);
        const bf16* wp = H + ((size_t)b * SEQ + CHUNK * c + ql0 + 2 * rb + hi) * LDH + C_WI;
        const v4u w0 = *(const v4u*)wp, w1 = *(const v4u*)(wp + 8);
        w[rb][0] = bflo(w0.x); w[rb][1] = bfhi(w0.x); w[rb][2] = bflo(w0.y); w[rb][3] = bfhi(w0.y); w[rb][4] = bflo(w0.z); w[rb][5] = bfhi(w0.z); w[rb][6] = bflo(w0.w); w[rb][7] = bfhi(w0.w);
        w[rb][8] = bflo(w1.x); w[rb][9] = bfhi(w1.x); w[rb][10] = bflo(w1.y); w[rb][11] = bfhi(w1.y); w[rb][12] = bflo(w1.z); w[rb][13] = bfhi(w1.z); w[rb][14] = bflo(w1.w); w[rb][15] = bfhi(w1.w);
#pragma unroll
        for (int r = 0; r < 16; ++r) w[rb][r] *= 0.5f;
        srow[rb] = SC + sc_base(b, c) + (size_t)(ql0 + 2 * rb + hi) * nk + r32;
    }
    const int srw = tid >> 3, sc16 = tid & 7;
    const bf16* kg = H + ((size_t)b * SEQ + srw) * LDH + C_KI + sc16 * 8;
    const int wofs = srw * 128 + ((sc16 ^ (srw & 7)) << 4);
    int rofs[4];
#pragma unroll
    for (int ks = 0; ks < 4; ++ks) rofs[ks] = r32 * 128 + (((2 * ks + hi) ^ (r32 & 7)) << 4);
    bf16x8 st = *(const bf16x8*)kg;
    *(LAS bf16x8*)(lds + wofs) = st;
    VM_WAIT();
    LDS_WAIT(); __syncthreads();
#define SC_STEP(KC, BUF, STW, STL) do { \
        LAS unsigned char* cur = lds + (BUF) * 8192; \
        if ((KC) + 2 <= c) STL = *(const bf16x8*)(kg + (size_t)((KC) + 2) * 64 * LDH); \
        _Pragma("unroll") for (int h = 0; h < 2; ++h) { \
            bf16x8 Bf[4]; \
            _Pragma("unroll") for (int ks = 0; ks < 4; ++ks) Bf[ks] = *(const LAS bf16x8*)(cur + h * 4096 + rofs[ks]); \
            _Pragma("unroll") for (int rb = 0; rb < 2; ++rb) { \
                f32x16 acc = f32x16{}; \
                _Pragma("unroll") for (int ks = 0; ks < 4; ++ks) acc = __builtin_amdgcn_mfma_f32_32x32x16_bf16(A[rb][ks], Bf[ks], acc, 0, 0, 0); \
                f32x2v s2 = f32x2v{0.f, 0.f};                                     \
                _Pragma("unroll") for (int r = 0; r < 16; r += 2) { float t0 = acc[r] + __builtin_fabsf(acc[r]), t1 = acc[r + 1] + __builtin_fabsf(acc[r + 1]); asm("" : "+v"(t0), "+v"(t1)); const f32x2v t = f32x2v{t0, t1};     \
                    s2 = __builtin_elementwise_fma(f32x2v{w[rb][r], w[rb][r + 1]}, t, s2); } \
                srow[rb][64 * (KC) + 32 * h] = s2.x + s2.y; } } \
        if ((KC) + 1 <= c) *(LAS bf16x8*)(lds + (1 - (BUF)) * 8192 + wofs) = STW; \
        LDS_WAIT(); __syncthreads(); } while (0)
    bf16x8 stA = st, stB = st;
    if (c >= 1) stA = *(const bf16x8*)(kg + (size_t)64 * LDH);
    for (int kc = 0; kc <= c; kc += 2) {
        SC_STEP(kc, 0, stA, stB);
        if (kc + 1 <= c) SC_STEP(kc + 1, 1, stB, stA);
    }
#undef SC_STEP
}
__device__ __forceinline__ void select_task(const float* __restrict__ SC, unsigned* __restrict__ maskw, int b, int c, int p, int lane_) {
    const int lane = pg8::opqv(lane_);
    const int r32 = lane & 31, hi = lane >> 5;
    const int t0 = CHUNK * c + 2 * p, nkb = 2 * (c + 1), nk = 64 * (c + 1);
    const float* sp = SC + sc_base(b, c) + (size_t)(2 * p + hi) * nk + r32;
    unsigned su[128];
#pragma unroll
    for (int j = 0; j < 128; ++j) su[j] = 0u;
#pragma unroll
    for (int g = 0; g < 8; ++g) { if (g * 16 < nkb) {
#pragma unroll
        for (int jj = 0; jj < 16; ++jj) { const int j = g * 16 + jj; if (j < nkb) { unsigned u = __float_as_uint(sp[32 * j]); u ^= (u >> 31) ? 0xffffffffu : 0x80000000u; su[j] = u; } } } }
    unsigned T = 1u;
    if (nkb * 32 > TOPK) {
        unsigned prefix = 0u; bool fin = false;
        for (int bit = 31; bit >= 0; --bit) {
            const unsigned cand = prefix | (1u << bit);
            int c0 = 0, c1 = 0, c2 = 0, c3 = 0;
#pragma unroll
            for (int g = 0; g < 8; ++g) { if (g * 16 < nkb) {
#pragma unroll
                for (int j = 0; j < 16; j += 4) { unsigned long long m0, m1, m2, m3;
                    asm volatile("v_cmp_ge_u32_e64 %[m0], %[a0], %[cd]\n\tv_cmp_ge_u32_e64 %[m1], %[a1], %[cd]\n\tv_cmp_ge_u32_e64 %[m2], %[a2], %[cd]\n\tv_cmp_ge_u32_e64 %[m3], %[a3], %[cd]\n\t"
                                 "v_addc_co_u32_e64 %[c0], %[m0], 0, %[c0], %[m0]\n\tv_addc_co_u32_e64 %[c1], %[m1], 0, %[c1], %[m1]\n\tv_addc_co_u32_e64 %[c2], %[m2], 0, %[c2], %[m2]\n\tv_addc_co_u32_e64 %[c3], %[m3], 0, %[c3], %[m3]"
                                 : [c0] "+v"(c0), [c1] "+v"(c1), [c2] "+v"(c2), [c3] "+v"(c3), [m0] "=&s"(m0), [m1] "=&s"(m1), [m2] "=&s"(m2), [m3] "=&s"(m3)
                                 : [a0] "v"(su[g * 16 + j]), [a1] "v"(su[g * 16 + j + 1]), [a2] "v"(su[g * 16 + j + 2]), [a3] "v"(su[g * 16 + j + 3]), [cd] "v"(cand)); } } }
            int cnt = (c0 + c1) + (c2 + c3);
            cnt += __builtin_amdgcn_update_dpp(0, cnt, 0xB1, 0xF, 0xF, true);
            cnt += __builtin_amdgcn_update_dpp(0, cnt, 0x4E, 0xF, 0xF, true);
            cnt += __builtin_amdgcn_update_dpp(0, cnt, 0x141, 0xF, 0xF, true);
            cnt += __builtin_amdgcn_update_dpp(0, cnt, 0x140, 0xF, 0xF, true);
            cnt += __shfl_xor(cnt, 16);
            if (!fin && cnt >= TOPK) prefix = cand;
            fin = fin || (cnt == TOPK);
            if (__all(fin)) break;
        }
        T = prefix > 1u ? prefix : 1u;
    }
    unsigned wA0 = 0u, wB0 = 0u, wA1 = 0u, wB1 = 0u;
#pragma unroll
    for (int g = 0; g < 8; ++g) { if (g * 16 < nkb) {
#pragma unroll
        for (int jj = 0; jj < 16; ++jj) { const int j = g * 16 + jj;
        const unsigned long long bal = __ballot(su[j] >= T);
        const unsigned lo = (unsigned)bal, hi32 = (unsigned)(bal >> 32);
        if (j < 64) { wA0 = (lane == j) ? lo : wA0; wA1 = (lane == j) ? hi32 : wA1; }
        else { wB0 = (lane == j - 64) ? lo : wB0; wB1 = (lane == j - 64) ? hi32 : wB1; }
        } } }
    unsigned* mrow = maskw + ((size_t)b * SEQ + t0) * 128;
    mrow[lane] = wA0; mrow[64 + lane] = wB0; mrow[128 + lane] = wA1; mrow[192 + lane] = wB1;
}

__device__ __forceinline__ void kiwi_task(LAS unsigned char* lds, const unsigned char* __restrict__ XQ_, const unsigned char* __restrict__ WQ, const float* __restrict__ sx, const float* __restrict__ swm,
                                          const float* __restrict__ ropeI, bf16* __restrict__ H, int row0, int wave, int tid_) {
    typedef int v4i __attribute__((ext_vector_type(4)));
    const int tid = pg8::opqv(tid_), lane = tid & 63, l15 = lane & 15, q = lane >> 4;
    const int colA = 8 * (l15 >> 3) + 2 * ((l15 >> 2) & 1) + (l15 & 1) + 4 * ((l15 >> 1) & 1);
    LAS int* red = (LAS int*)lds;
    for (int i = tid; i < 20 * 256; i += NWAVES * 64) red[i] = 0;
    const unsigned char* bp = XQ_ + (size_t)(row0 + l15) * DM + wave * 256 + 16 * q;
    const unsigned char* ap = WQ + (size_t)colA * DM + wave * 256 + 16 * q;
    v4i acc[4][5];
#pragma unroll
    for (int rt = 0; rt < 4; ++rt)
#pragma unroll
        for (int ct = 0; ct < 5; ++ct) acc[rt][ct] = v4i{0, 0, 0, 0};
#pragma unroll 1
    for (int hb = 0; hb < 2; ++hb) {
        v4i bf[4][2], af[5][2];
#pragma unroll
        for (int rt = 0; rt < 4; ++rt)
#pragma unroll
            for (int ks = 0; ks < 2; ++ks) bf[rt][ks] = *(const v4i*)(bp + (size_t)rt * 16 * DM + ks * 64);
#pragma unroll
        for (int ct = 0; ct < 5; ++ct)
#pragma unroll
            for (int ks = 0; ks < 2; ++ks) af[ct][ks] = *(const v4i*)(ap + (size_t)ct * 16 * DM + ks * 64);
#pragma unroll
        for (int ks = 0; ks < 2; ++ks)
#pragma unroll
            for (int rt = 0; rt < 4; ++rt)
#pragma unroll
                for (int ct = 0; ct < 5; ++ct) acc[rt][ct] = __builtin_amdgcn_mfma_i32_16x16x64_i8(af[ct][ks], bf[rt][ks], acc[rt][ct], 0, 0, 0);
        bp += 128; ap += 128;
    }
    LDS_WAIT(); __syncthreads();
#pragma unroll
    for (int rt = 0; rt < 4; ++rt)
#pragma unroll
        for (int ct = 0; ct < 5; ++ct)
#pragma unroll
            for (int r = 0; r < 4; ++r) __hip_atomic_fetch_add(red + ((rt * 5 + ct) * 4 + r) * 64 + lane, acc[rt][ct][r], __ATOMIC_RELAXED, __HIP_MEMORY_SCOPE_WORKGROUP);
    LDS_WAIT(); __syncthreads();
    for (int t = wave; t < 20; t += NWAVES) {
        const int rt = t / 5, ct = t - 5 * rt, row = row0 + 16 * rt + l15;
        const float rs = sx[row];
        bf16* hrow = H + (size_t)row * LDH + C_KI;
        const int s0 = red[(t * 4 + 0) * 64 + lane], s1 = red[(t * 4 + 1) * 64 + lane], s2 = red[(t * 4 + 2) * 64 + lane], s3 = red[(t * 4 + 3) * 64 + lane];
        const int cb = 16 * ct + 8 * (q >> 1) + 2 * (q & 1);
        const float* sw = swm + C_KI + cb;
        float v0 = (float)s0 * (sw[0] * (1.0f / 127.0f)) * rs, v1 = (float)s1 * (sw[1] * (1.0f / 127.0f)) * rs;
        float v2 = (float)s2 * (sw[4] * (1.0f / 127.0f)) * rs, v3 = (float)s3 * (sw[5] * (1.0f / 127.0f)) * rs;
        if (ct < 4) {
            const f32x4 tb = *(const f32x4*)(ropeI + ((size_t)row * 32 + 4 * (2 * ct + (q >> 1)) + 2 * (q & 1)) * 2);
            const float y0 = v0 * tb[0] - v2 * tb[1], y2 = v2 * tb[0] + v0 * tb[1], y1 = v1 * tb[2] - v3 * tb[3], y3 = v3 * tb[2] + v1 * tb[3];
            v0 = y0; v1 = y1; v2 = y2; v3 = y3; }
        *(unsigned*)(hrow + cb) = cvtpk(v0, v1); *(unsigned*)(hrow + cb + 4) = cvtpk(v2, v3);
    }
    LDS_WAIT(); __syncthreads();
}
constexpr size_t MiB = 1u << 20;
constexpr size_t WS_CTL = 0, CTL_ZERO_BYTES = 2 * MiB;
constexpr int CW_TMO = 0, CW_BAR = 4096;
constexpr size_t WS_SWMAX = 512 * 1024;
constexpr int SWM_WIN = 0, SWM_FGU = 2 * LDH, SWM_MGU = SWM_FGU + 2 * DFF, SWM_PA = SWM_MGU + NEXP * 2 * DEXP, SWM_PB = SWM_PA + 2 * DM, SWM_VMAX = SWM_PB + 2 * DM  , SWM_END = SWM_VMAX + 4;
static_assert(WS_SWMAX + (size_t)SWM_END * 4 <= CTL_ZERO_BYTES, "absmax words inside the memset region");
constexpr size_t WS_WINQ = 2 * MiB;
constexpr size_t WS_PA = WS_WINQ + 2 * (size_t)LDH * DM;
constexpr size_t WS_PB = WS_PA + 2 * (size_t)DM * 1024;
constexpr size_t WS_WOUT = WS_PB + 2 * (size_t)DM * 1024;
constexpr size_t WS_FGUQ = WS_WOUT + 2 * (size_t)DM * DM * 2;
constexpr size_t WS_FD = WS_FGUQ + (size_t)2 * DFF * DM;
constexpr size_t WS_MGUQ = WS_FD + (size_t)DM * DFF * 2;
constexpr size_t WS_MD = WS_MGUQ + (size_t)NEXP * 2 * DEXP * DM;
constexpr size_t WS_XS = WS_MD + (size_t)NEXP * DM * DEXP * 2;
constexpr size_t WS_XQ = WS_XS + (size_t)MTOK * DM * 2;
constexpr size_t WS_SX = WS_XQ + (size_t)MTOK * DM;
constexpr size_t WS_STATS = WS_SX + (size_t)MTOK * 4;
constexpr size_t WS_ROPEH = WS_STATS + (size_t)MTOK * 8;
constexpr size_t WS_ROPEI = WS_ROPEH + (size_t)MTOK * 64 * 2 * 4;
constexpr size_t WS_TOK = WS_ROPEI + (size_t)MTOK * 32 * 2 * 4;
constexpr size_t WS_BCNT = WS_TOK + (size_t)MTOK * 16;
constexpr size_t WS_ARENA = (WS_BCNT + 256 * 8 * 4 + 64 + MiB - 1) / MiB * MiB;
constexpr size_t WS_H = WS_ARENA;
constexpr size_t WS_OA = WS_H + (size_t)MTOK * LDH * 2;
constexpr size_t WS_OB = WS_OA + (size_t)MTOK * 1024;
constexpr size_t WS_MG = WS_OB + (size_t)MTOK * 1024;
constexpr size_t WS_MASK = WS_MG + (size_t)MTOK * DM * 2;
constexpr size_t WS_SC = WS_MASK + (size_t)MTOK * 64 * 8;
constexpr size_t WS_MIX_END = WS_SC + (size_t)BATCH * 2048 * 64 * 65 * 4;
constexpr size_t WS_HD = WS_ARENA;
constexpr size_t WS_XGQ = WS_ARENA;
constexpr size_t WS_SO = WS_ARENA;
constexpr size_t WS_HDM = WS_SO + (size_t)MAXSLOT * DM * 2;
constexpr size_t WS_SXG = WS_HDM + (size_t)MAXSLOT * DEXP * 2;
constexpr size_t WS_PART = (WS_SXG + (size_t)MAXSLOT * 4 + 255) / 256 * 256;
constexpr size_t WS_FFN_END = WS_PART + (size_t)7 * 2048 * DM * 4;
constexpr size_t WS_END = WS_MIX_END > WS_FFN_END ? WS_MIX_END : WS_FFN_END;

constexpr int RING_OFF = 0, RING_BYTES = 131072;
constexpr int LDSCTL_OFF = RING_BYTES, MISC_OFF = LDSCTL_OFF + 320;
static_assert(MISC_OFF + 8192 == 139584, "gemm_phase PF_OFF");
constexpr int LDS_BYTES = 147456;

#define XB_TMO      128
#define XB_XCNT(j)  (256  + 64 * (j))
#define XB_XSUB(j)  (1280 + 64 * (j))
#define XB_XGEN(j)  (2304 + 64 * (j))
#define XB_TOP      3328
#define XB_TOPGEN   3392
#define XCD_BAR_WORDS 3456
#define XB_SPIN_CAP (1u << 20)
__device__ __forceinline__ unsigned xb_ld(unsigned* p)              { return __hip_atomic_load(p, __ATOMIC_RELAXED, __HIP_MEMORY_SCOPE_AGENT); }
__device__ __forceinline__ unsigned xb_add(unsigned* p, unsigned v) { return __hip_atomic_fetch_add(p, v, __ATOMIC_RELAXED, __HIP_MEMORY_SCOPE_AGENT); }
__device__ __forceinline__ unsigned xb_xcc_id() { return (unsigned)__builtin_amdgcn_s_getreg((3 << 11) | 20) & 0xFu; }
#define XB_SPIN(cond, bar) do { unsigned _sp = 0; while (cond) { __builtin_amdgcn_s_sleep(1); \
    if ((++_sp & 255u) == 0u) { if (xb_ld(&(bar)[XB_TMO])) break; if (_sp > XB_SPIN_CAP) { atomicAdd(&(bar)[XB_TMO], 1u); break; } } } } while (0)
struct XcdBarrier { unsigned* bar; unsigned x; volatile LAS unsigned* st; };
__device__ __forceinline__ XcdBarrier xcd_barrier_post(unsigned* bar, volatile LAS unsigned* st) {
    XcdBarrier b; b.bar = bar; b.x = xb_xcc_id(); b.st = st;
    if (threadIdx.x == 0) (void)xb_add(&bar[XB_XCNT(b.x)], 1u);
    return b;
}
__device__ __forceinline__ void xcd_barrier_complete(unsigned* bar, unsigned x, unsigned& nloc, unsigned& nx) {
    const unsigned G = gridDim.x * gridDim.y * gridDim.z;
    unsigned sum, cnt, mine, sp = 0u;
    for (;;) {
        sum = 0u; cnt = 0u; mine = 0u;
#pragma unroll
        for (unsigned j = 0; j < 16; ++j) { const unsigned c = xb_ld(&bar[XB_XCNT(j)]); sum += c; cnt += (c > 0u) ? 1u : 0u; mine = (j == x) ? c : mine; }
        if (sum == G) break;
        __builtin_amdgcn_s_sleep(1);
        if ((++sp & 255u) == 0u) { if (xb_ld(&bar[XB_TMO])) break; if (sp > XB_SPIN_CAP) { atomicAdd(&bar[XB_TMO], 1u); break; } }
    }
    nloc = mine > 0u ? mine : 1u; nx = cnt > 0u ? cnt : 1u;
}
__device__ __forceinline__ void xcd_barrier(const XcdBarrier& b) {
    asm volatile("s_waitcnt vmcnt(0)" ::: "memory");
    __syncthreads();
    if (threadIdx.x == 0) {
        unsigned* bar = b.bar;
        __builtin_amdgcn_s_waitcnt(0);
        unsigned nloc = b.st[0], nx = b.st[1];
        if (nloc == 0u) { xcd_barrier_complete(bar, b.x, nloc, nx); b.st[0] = nloc; b.st[1] = nx; }
        const unsigned old = xb_add(&bar[XB_XSUB(b.x)], 1u);
        const unsigned gen = old / nloc;
        if (old + 1u == (gen + 1u) * nloc) {
            __builtin_amdgcn_fence(__ATOMIC_RELEASE, "agent");
            asm volatile("s_waitcnt vmcnt(0)" ::: "memory");
            const unsigned og = xb_add(&bar[XB_TOP], 1u);
            const unsigned tg = og / nx;
            if (og + 1u == (tg + 1u) * nx) xb_add(&bar[XB_TOPGEN], 1u);
            else XB_SPIN(xb_ld(&bar[XB_TOPGEN]) == tg, bar);
            __builtin_amdgcn_fence(__ATOMIC_ACQUIRE, "agent");
            xb_add(&bar[XB_XGEN(b.x)], 1u);
            asm volatile("s_waitcnt vmcnt(0)" ::: "memory");
        } else {
            XB_SPIN(xb_ld(&bar[XB_XGEN(b.x)]) == gen, bar);
            __builtin_amdgcn_fence(__ATOMIC_ACQUIRE, "agent");
            asm volatile("s_waitcnt vmcnt(0)" ::: "memory");
        }
    }
    __syncthreads();
}

__device__ __forceinline__ float wave_sum(float v) {
#pragma unroll
    for (int o = 1; o < 64; o <<= 1) v += __shfl_xor(v, o);
    return v;
}
__device__ __forceinline__ unsigned xshf(unsigned x, int s) {
    if (s == 1) return (unsigned)__builtin_amdgcn_update_dpp(0, (int)x, 0xB1, 0xF, 0xF, true);
    if (s == 2) return (unsigned)__builtin_amdgcn_update_dpp(0, (int)x, 0x4E, 0xF, 0xF, true);
    const int t = __builtin_amdgcn_update_dpp(0, (int)x, 0x141, 0xF, 0xF, true);
    return (unsigned)__builtin_amdgcn_update_dpp(0, t, 0x1B, 0xF, 0xF, true);
}
__device__ __forceinline__ void tr8x8(v4u (&E)[8], int lane) {
#pragma unroll
    for (int s = 4; s >= 1; s >>= 1) {
        const bool up = (lane & s) != 0;
#pragma unroll
        for (int j = 0; j < 8; ++j) if ((j & s) == 0) {
            const v4u a = E[j], b = E[j | s]; v4u r;
            r.x = xshf(up ? a.x : b.x, s); r.y = xshf(up ? a.y : b.y, s); r.z = xshf(up ? a.z : b.z, s); r.w = xshf(up ? a.w : b.w, s);
            E[j].x = up ? r.x : a.x; E[j].y = up ? r.y : a.y; E[j].z = up ? r.z : a.z; E[j].w = up ? r.w : a.w;
            E[j | s].x = up ? b.x : r.x; E[j | s].y = up ? b.y : r.y; E[j | s].z = up ? b.z : r.z; E[j | s].w = up ? b.w : r.w;
        }
    }
}
__device__ __forceinline__ int dst_row(int type, int off, int n) {
    if (type == 0) return n + off;
    if (type == 1) return 256 * (n >> 7) + off + (n & 127);
    if (n < 2048) { const int d = n & 127, i = d & 63, hf = d >> 6; return (n & ~127) + 8 * (i >> 2) + (i & 3) + 4 * hf; }
    if (n < 3072) return n;
    if (n < 4096) { const int d = n & 63, i = d & 31, hf = d >> 5; return (n & ~63) + 8 * (i >> 2) + (i & 3) + 4 * hf; }
    if (n < 4160) { const int d = n - 4096, i = d & 31, hf = d >> 5; return C_KI + 8 * (i >> 2) + (i & 3) + 4 * hf; }
    if (n < 4176) return n + (C_KI - 4096);
    return n - 80;
}
__device__ __forceinline__ void tr_item(const float* __restrict__ W, int K, int N, bf16* __restrict__ WT, int type, int off, int item, int lane) {
    const int nblk = (N + 63) >> 6, kb = item / nblk, nb = item - kb * nblk, k0 = 64 * kb, n = 64 * nb + lane;
    const float* src = W + (size_t)k0 * N + n;
    float v[64];
#pragma unroll
    for (int k = 0; k < 64; ++k) { v[k] = __builtin_nontemporal_load(src); src += N; }
    v4u o[8];
#pragma unroll
    for (int j = 0; j < 8; ++j) { o[j].x = pk2(v[8 * j], v[8 * j + 1]); o[j].y = pk2(v[8 * j + 2], v[8 * j + 3]); o[j].z = pk2(v[8 * j + 4], v[8 * j + 5]); o[j].w = pk2(v[8 * j + 6], v[8 * j + 7]); }
    tr8x8(o, lane);
    const int il = lane & 7;
#pragma unroll
    for (int c = 0; c < 8; ++c) *(v4u*)(WT + (size_t)dst_row(type, off, n - il + c) * K + k0 + 8 * il) = o[c];
}
__device__ __forceinline__ unsigned pack4q(float a, float b, float c, float d, float inv) {
    const int q0 = __float2int_rn(a * inv), q1 = __float2int_rn(b * inv), q2 = __float2int_rn(c * inv), q3 = __float2int_rn(d * inv);
    return ((unsigned)q0 & 0xffu) | (((unsigned)q1 & 0xffu) << 8) | (((unsigned)q2 & 0xffu) << 16) | ((unsigned)q3 << 24);
}
__device__ __forceinline__ void amax_item(const float* __restrict__ W, int K, int N, unsigned* __restrict__ swmax, int type, int off, int item, int lane) {
    const int nblk = (N + 63) >> 6, kq = item / nblk, nb = item - kq * nblk, n = 64 * nb + lane, kr = K >> 2;
    if (n < N) {
        const float* src = W + (size_t)(kq * kr) * N + n; float am = 0.f;
        for (int kb = 0; kb < (kr >> 6); ++kb) {
            float v[64];
#pragma unroll
            for (int k = 0; k < 64; ++k) { v[k] = *src; src += N; }
#pragma unroll
            for (int k = 0; k < 64; ++k) am = fmaxf(am, fabsf(v[k]));
        }
        atomicMax(swmax + dst_row(type, off, n), __float_as_uint(am));
    }
}
__device__ __forceinline__ void quant_item(const float* __restrict__ W, int K, int N, unsigned char* __restrict__ WQ, const unsigned* __restrict__ swmax, int type, int off, int item, int lane) {
    const int nblk = (N + 63) >> 6, kb = item / nblk, nb = item - kb * nblk, k0 = 128 * kb, n = 64 * nb + lane;
    if (n < N) {
        const int dr = dst_row(type, off, n); const float am = __uint_as_float(swmax[dr]); const float inv = am > 0.f ? 127.0f / am : 0.f;
        const float* src = W + (size_t)k0 * N + n;
        float v[128];
#pragma unroll
        for (int k = 0; k < 128; ++k) { v[k] = __builtin_nontemporal_load(src); src += N; }
        unsigned char* dst = WQ + (size_t)dr * K + k0;
#pragma unroll
        for (int j = 0; j < 8; ++j) { v4u o; o.x = pack4q(v[16 * j], v[16 * j + 1], v[16 * j + 2], v[16 * j + 3], inv); o.y = pack4q(v[16 * j + 4], v[16 * j + 5], v[16 * j + 6], v[16 * j + 7], inv);
            o.z = pack4q(v[16 * j + 8], v[16 * j + 9], v[16 * j + 10], v[16 * j + 11], inv); o.w = pack4q(v[16 * j + 12], v[16 * j + 13], v[16 * j + 14], v[16 * j + 15], inv);
            *(v4u*)(dst + 16 * j) = o; }
    }
}
__device__ __forceinline__ void quant_tile(LAS unsigned* colmax, const float* __restrict__ W, int K, int N, unsigned char* __restrict__ WQ, unsigned* __restrict__ swmax, int type, int off, int tile, int tid) {
    const int nwl = (K == 2048) ? 5 : 6, nw = 1 << nwl;
    const int nl = tid & (nw - 1), kg = tid >> nwl, n = tile * nw + nl, k0 = kg * 128;
    const bool ok = n < N;
    if (tid < 64) colmax[tid] = 0u;
    float v[128]; float am = 0.f;
    if (ok) { const float* src = W + (size_t)k0 * N + n;
#pragma unroll
        for (int k = 0; k < 128; ++k) { v[k] = __builtin_nontemporal_load(src); src += N; }
#pragma unroll
        for (int k = 0; k < 128; ++k) am = fmaxf(am, fabsf(v[k])); }
    __syncthreads();
    if (ok) __hip_atomic_fetch_max(colmax + nl, __float_as_uint(am), __ATOMIC_RELAXED, __HIP_MEMORY_SCOPE_WORKGROUP);
    __syncthreads();
    v4u o[8];
    { const float cm = __uint_as_float(colmax[nl]); const float inv = (ok && cm > 0.f) ? 127.0f / cm : 0.f;
      if (ok && kg == 0) swmax[dst_row(type, off, n)] = __float_as_uint(cm);
#pragma unroll
      for (int j = 0; j < 8; ++j) { if (ok) { o[j].x = pack4q(v[16 * j], v[16 * j + 1], v[16 * j + 2], v[16 * j + 3], inv); o[j].y = pack4q(v[16 * j + 4], v[16 * j + 5], v[16 * j + 6], v[16 * j + 7], inv);
            o[j].z = pack4q(v[16 * j + 8], v[16 * j + 9], v[16 * j + 10], v[16 * j + 11], inv); o[j].w = pack4q(v[16 * j + 12], v[16 * j + 13], v[16 * j + 14], v[16 * j + 15], inv); }
          else o[j] = (v4u){0u, 0u, 0u, 0u}; } }
    tr8x8(o, tid);
    { const int il = tid & 7;
      if (ok) {
#pragma unroll
        for (int c = 0; c < 8; ++c) *(v4u*)(WQ + (size_t)dst_row(type, off, n - il + c) * K + k0 + 16 * il) = o[c]; } }
    __syncthreads();
}
struct Ptrs {
    const float* x; const int* pos; const float* ln_in_g; const float* ln_in_b; const float* w_in; const float* w_proj_a; const float* w_proj_b; const float* w_out;
    const float* ln_mix_g; const float* ln_mix_b; const float* ffn_w_gate; const float* ffn_w_up; const float* ffn_w_down; const float* router_w;
    const float* moe_w_gate; const float* moe_w_up; const float* moe_w_down; const float* ln_ffn_g; const float* ln_ffn_b;
    float* out; unsigned char* ws; int ph_lo, ph_hi, li, pad;
};
__device__ __forceinline__ void ln_regs(f32x4 (&v)[8], const float* __restrict__ g, const float* __restrict__ bta, int lane, float* stat = nullptr) {
    float s = 0.f;
#pragma unroll
    for (int j = 0; j < 8; ++j) s += (v[j].x + v[j].y) + (v[j].z + v[j].w);
    const float mean = wave_sum(s) * (1.f / DM); float s2 = 0.f;
#pragma unroll
    for (int j = 0; j < 8; ++j) { v[j] = v[j] - mean; s2 += (v[j].x * v[j].x + v[j].y * v[j].y) + (v[j].z * v[j].z + v[j].w * v[j].w); }
    const float rstd = 1.f / sqrtf(wave_sum(s2) * (1.f / DM) + LN_EPS);
    if (stat && lane == 0) { stat[0] = mean; stat[1] = rstd; }
#pragma unroll
    for (int j = 0; j < 8; ++j) { const f32x4 gg = *((const f32x4*)g + lane + 64 * j), bb = *((const f32x4*)bta + lane + 64 * j); v[j] = v[j] * rstd * gg + bb; }
}
__device__ __forceinline__ void ln_regs_r(f32x4 (&v)[8], const f32x4 (&gg)[8], const f32x4 (&bb)[8], int lane, float* stat = nullptr) {
    float s = 0.f;
#pragma unroll
    for (int j = 0; j < 8; ++j) s += (v[j].x + v[j].y) + (v[j].z + v[j].w);
    const float mean = wave_sum(s) * (1.f / DM); float s2 = 0.f;
#pragma unroll
    for (int j = 0; j < 8; ++j) { v[j] = v[j] - mean; s2 += (v[j].x * v[j].x + v[j].y * v[j].y) + (v[j].z * v[j].z + v[j].w * v[j].w); }
    const float rstd = 1.f / sqrtf(wave_sum(s2) * (1.f / DM) + LN_EPS);
    if (stat && lane == 0) { stat[0] = mean; stat[1] = rstd; }
#pragma unroll
    for (int j = 0; j < 8; ++j) v[j] = v[j] * rstd * gg[j] + bb[j];
}
__device__ __forceinline__ float wave_max(float v) {
#pragma unroll
    for (int o = 1; o < 64; o <<= 1) v = fmaxf(v, __shfl_xor(v, o));
    return v;
}
__device__ __forceinline__ void store_row(const f32x4 (&v)[8], float* xs_row, unsigned char* xq_row, float* sx, int lane) {
    if (xs_row) {
#pragma unroll
        for (int j = 0; j < 8; ++j) *((f32x4*)xs_row + lane + 64 * j) = v[j]; }
    if (xq_row) {
        float am = 0.f;
#pragma unroll
        for (int j = 0; j < 8; ++j) am = fmaxf(fmaxf(am, fmaxf(fabsf(v[j].x), fabsf(v[j].y))), fmaxf(fabsf(v[j].z), fabsf(v[j].w)));
        am = wave_max(am);
        const float inv = am > 0.f ? 127.0f / am : 0.f;
#pragma unroll
        for (int j = 0; j < 8; ++j) *((unsigned*)xq_row + lane + 64 * j) = pack4q(v[j].x, v[j].y, v[j].z, v[j].w, inv);
        if (lane == 0) *sx = am * (1.0f / 127.0f);
    }
}
#ifndef MK_ONE_LAUNCH
#define MK_ONE_LAUNCH 1
#endif
#ifndef MK_SKIP_MIXER
#define MK_SKIP_MIXER 0
#endif
#ifndef MK_PHASE_MASK
#define MK_PHASE_MASK 0xFFFF
#endif
#define PH_ON(k) (((MK_PHASE_MASK) >> (k)) & 1)
#ifndef MK_REP_MASK
#define MK_REP_MASK 0ull
#endif
#define REPN(p) ((((unsigned long long)(MK_REP_MASK)) >> (p)) & 1ull ? 2 : 1)
constexpr int PRO_NC = 1;
constexpr int PRO_PH = 1 + PRO_NC, PH_PER_LAYER = 11, N_PHASES = PRO_PH + 2 * PH_PER_LAYER;
__device__ __forceinline__ void pro_chunk(int c, int& a0, int& a0n, int& a1, int& a1n, int& q0, int& q0n, int& q1, int& q1n) {
    (void)c; a0 = 0; a0n = 9808; a1 = 0; a1n = 0; q0 = 0; q0n = 38208; q1 = 0; q1n = 0;
}

__device__ __forceinline__ void load_row(f32x4 (&v)[8], const bf16* row, int lane) {
#pragma unroll
    for (int j = 0; j < 8; ++j) { const v2u w = *((const v2u*)row + lane + 64 * j); v[j] = (f32x4){bflo(w.x), bfhi(w.x), bflo(w.y), bfhi(w.y)}; }
}
__device__ __forceinline__ void load_row(f32x4 (&v)[8], const float* row, int lane) {
#pragma unroll
    for (int j = 0; j < 8; ++j) v[j] = *((const f32x4*)row + lane + 64 * j);
}

template <class T> __device__ __forceinline__ T* opq(T* p) { asm volatile("" : "+s"(p)); return p; }
__device__ __forceinline__ int opqi(int v) { asm volatile("" : "+s"(v)); return v; }
using pg8::ldptr;
__global__ void __launch_bounds__(NWAVES * 64, 2) fwd_kernel(Ptrs a) {
    extern __shared__ __attribute__((aligned(16))) unsigned char lds_raw[];
    LAS unsigned char* lds = (LAS unsigned char*)lds_raw;
    volatile LAS unsigned* MISC = (volatile LAS unsigned*)(lds + MISC_OFF);
    const int tid0 = threadIdx.x, lane0 = tid0 & 63, wave = __builtin_amdgcn_readfirstlane(tid0 >> 6);
    const int G = gridDim.x, blk = blockIdx.x;
    const int gw = blk * NWAVES + wave, NGW = G * NWAVES;
    for (int u = tid0; u < (LDS_BYTES - LDSCTL_OFF) / 4; u += NWAVES * 64) ((LAS unsigned*)(lds + LDSCTL_OFF))[u] = 0u;
    __syncthreads();
    volatile LAS unsigned* PT = (volatile LAS unsigned*)(lds + MISC_OFF + 2048);
    if (tid0 == 0) {
#define PUTP(k, p) do { const unsigned long long v_ = (unsigned long long)(p); PT[2 * (k)] = (unsigned)v_; PT[2 * (k) + 1] = (unsigned)(v_ >> 32); } while (0)
        PUTP(0, a.x);         PUTP(1, a.pos);         PUTP(2, a.ln_in_g);         PUTP(3, a.ln_in_b);
        PUTP(4, a.w_in);         PUTP(5, a.w_proj_a);         PUTP(6, a.w_proj_b);         PUTP(7, a.w_out);
        PUTP(8, a.ln_mix_g);         PUTP(9, a.ln_mix_b);         PUTP(10, a.ffn_w_gate);         PUTP(11, a.ffn_w_up);
        PUTP(12, a.ffn_w_down);         PUTP(13, a.router_w);         PUTP(14, a.moe_w_gate);         PUTP(15, a.moe_w_up);
        PUTP(16, a.moe_w_down);         PUTP(17, a.ln_ffn_g);         PUTP(18, a.ln_ffn_b);         PUTP(19, a.out);
PUTP(20, a.ws); PUTP(21, a.ws + WS_XS); PUTP(22, a.ws + WS_STATS);
#undef PUTP
    }
    const int a_lo = a.ph_lo, a_hi = a.ph_hi, a_li = a.li;
    __syncthreads();
#define WINQ (ws + WS_WINQ)
#define PAQ (ws + WS_PA)
#define PBQ (ws + WS_PB)
#define WOUT_T ((bf16*)(ws + WS_WOUT))
#define FGUQ (ws + WS_FGUQ)
#define FD_T ((bf16*)(ws + WS_FD))
#define MGUQ (ws + WS_MGUQ)
#define MD_T ((bf16*)(ws + WS_MD))
#define XS ((bf16*)(ws + WS_XS))
#define XQ (ws + WS_XQ)
#define SX ((float*)(ws + WS_SX))
#define STATS ((float*)(ws + WS_STATS))
#define SWMAX ((unsigned*)(ws + WS_SWMAX))
#define ROPEH ((float*)(ws + WS_ROPEH))
#define ROPEI ((float*)(ws + WS_ROPEI))
#define TOK ((unsigned*)(ws + WS_TOK))
#define BCNT ((unsigned*)(ws + WS_BCNT))
#define META (BCNT + 256 * 8)
#define Hb ((bf16*)(ws + WS_H))
#define OA (ws + WS_OA)
#define OB (ws + WS_OB)
#define MG ((bf16*)(ws + WS_MG))
#define MASK ((unsigned long long*)(ws + WS_MASK))
#define SC ((float*)(ws + WS_SC))
#define HDb ((bf16*)(ws + WS_HD))
#define XGQ (ws + WS_XGQ)
#define SO ((bf16*)(ws + WS_SO))
#define HDM ((bf16*)(ws + WS_HDM))
#define SXG ((float*)(ws + WS_SXG))
#define PART ((float*)(ws + WS_PART))
    unsigned char* ws0 = (unsigned char*)ldptr(PT, 20);
    gu32* ctl = (gu32*)(ws0 + WS_CTL);
    XcdBarrier bar = xcd_barrier_post((unsigned*)(ctl + CW_BAR) + a_li * XCD_BAR_WORDS, MISC + 8);
    const int lo = MK_ONE_LAUNCH ? 0 : a_lo, hi = MK_ONE_LAUNCH ? N_PHASES : a_hi;
#define IN(k) (lo <= (k) && (k) < hi)
#ifndef MK_EXTRA_BAR
#define MK_EXTRA_BAR 0
#endif
#define SEAM(k) do { if ((k) + 1 < hi) xcd_barrier(bar); } while (0)

    if (PH_ON(11) && IN(0)) {
            const int tid = pg8::opqv(tid0), lane = tid & 63; (void)lane; unsigned char* ws = (unsigned char*)ldptr(PT, 20); (void)ws;
            for (int rep_ = REPN(0); rep_ > 0; --rep_) {
        for (int idx = gw; idx < 33536; idx += NGW) {
            int s, it; if (idx < 2048) { s = 4 + (idx >> 10); it = idx & 1023; } else if (idx < 4864) { s = 6; it = idx - 2048; } else { const int q = (idx - 4864) / 3584; s = 7 + q; it = idx - 4864 - q * 3584; }
            const float* src; bf16* dst; int K, N;
            if (s < 6) { src = ((const float*)ldptr(PT, 7)) + (size_t)(s - 4) * DM * DM; dst = WOUT_T + (size_t)(s - 4) * DM * DM; K = DM; N = DM; }
            else if (s == 6) { src = ((const float*)ldptr(PT, 12)); dst = FD_T; K = DFF; N = DM; }
            else { const int e = s - 7; src = ((const float*)ldptr(PT, 16)) + (size_t)e * DEXP * DM; dst = MD_T + (size_t)e * DM * DEXP; K = DEXP; N = DM; }
            tr_item(src, K, N, dst, 0, 0, it, lane);
        }
        for (int idx = gw * 64 + lane; idx < MTOK * 64; idx += NGW * 64) { const int m = idx >> 6, i = idx & 63;
            const float inv = exp2f(-(float)(2 * i) * (1.0f / 128.0f) * 13.287712379549449f); const float ang = (float)((const int*)ldptr(PT, 1))[m] * inv; float sn, cs; sincosf(ang, &sn, &cs);
            ROPEH[(size_t)idx * 2] = cs; ROPEH[(size_t)idx * 2 + 1] = sn; }
        for (int idx = gw * 64 + lane; idx < MTOK * 32; idx += NGW * 64) { const int m = idx >> 5, i = idx & 31;
            const float inv = exp2f(-(float)(2 * i) * (1.0f / 64.0f) * 13.287712379549449f); const float ang = (float)((const int*)ldptr(PT, 1))[m] * inv; float sn, cs; sincosf(ang, &sn, &cs);
            ROPEI[(size_t)idx * 2] = cs; ROPEI[(size_t)idx * 2 + 1] = sn; }
        for (int m = gw; m < MTOK; m += NGW) { f32x4 v[8]; load_row(v, ((const float*)ldptr(PT, 0)) + (size_t)m * DM, lane); ln_regs(v, ((const float*)ldptr(PT, 2)), ((const float*)ldptr(PT, 3)), lane, STATS + 2 * m); store_row(v, nullptr, XQ + (size_t)m * DM, SX + m, lane); }
            }
    }
    if (PH_ON(11) && IN(1)) {
        const int tid = pg8::opqv(tid0), lane = tid & 63; (void)lane; unsigned char* ws = (unsigned char*)ldptr(PT, 20); (void)ws;
        for (int rep_ = REPN(1); rep_ > 0; --rep_) {
        LAS unsigned* colmax = (LAS unsigned*)(lds + RING_OFF);
        for (int idx = blk; idx < 4774; idx += G) {
            int s_, it;
            if (idx < 710) { s_ = idx / 355; it = idx - s_ * 355; } else if (idx < 1062) { const int q = (idx - 710) / 176; s_ = 2 + q; it = idx - 710 - q * 176; }
            else if (idx < 4646) { const int q = (idx - 1062) / 224; s_ = 4 + q; it = idx - 1062 - q * 224; } else { s_ = 20 + ((idx - 4646) >> 5); it = (idx - 4646) & 31; }
            if (s_ >= 20) { const int l = (s_ - 20) & 1, pbm = (s_ - 20) >> 1;
                quant_tile(colmax, (pbm ? ((const float*)ldptr(PT, 6)) : ((const float*)ldptr(PT, 5))) + (size_t)l * 1024 * DM, 1024, DM, (pbm ? PBQ : PAQ) + (size_t)l * DM * 1024, SWMAX + (pbm ? SWM_PB : SWM_PA) + l * DM, 0, 0, it, tid); }
            else { const float* src; unsigned char* dst; int N, type, off = 0, so;
                if (s_ < 2) { src = ((const float*)ldptr(PT, 4)) + (size_t)s_ * DM * INCOLS; dst = WINQ + (size_t)s_ * LDH * DM; N = INCOLS; type = 2; so = SWM_WIN + s_ * LDH; }
                else if (s_ < 4) { src = (s_ == 2) ? ((const float*)ldptr(PT, 10)) : ((const float*)ldptr(PT, 11)); dst = FGUQ; N = DFF; type = 1; off = (s_ == 2) ? 0 : 128; so = SWM_FGU; }
                else { const int e = (s_ - 4) >> 1, up = (s_ - 4) & 1; src = (up ? ((const float*)ldptr(PT, 15)) : ((const float*)ldptr(PT, 14))) + (size_t)e * DM * DEXP; dst = MGUQ + (size_t)e * 2 * DEXP * DM; N = DEXP; type = 1; off = up ? 128 : 0; so = SWM_MGU + e * 2 * DEXP; }
                quant_tile(colmax, src, DM, N, dst, SWMAX + so, type, off, it, tid); }
        }
        }
        SEAM(1);
    }

    {
        constexpr int L = 0;
        const int pb = PRO_PH + PH_PER_LAYER * L;
        if (PH_ON(0) && IN(pb + 0)) {
            const int tid = pg8::opqv(tid0), lane = tid & 63; (void)lane; unsigned char* ws = (unsigned char*)ldptr(PT, 20); (void)ws;
            for (int rep_ = REPN(pb + 0); rep_ > 0; --rep_) {
            if (!MK_SKIP_MIXER) {
            for (int u = blk; u < 256; u += G) kiwi_task(lds + RING_OFF, XQ, WINQ + ((size_t)L * LDH + C_KI) * DM, SX, (const float*)(SWMAX + SWM_WIN + L * LDH), ROPEI, Hb, 64 * u, wave, tid);
            pg8::Gemm g{opq(XQ), opq(WINQ + (size_t)L * LDH * DM), MTOK, LDH - 256, DM, DM}; pg8::StaticOrder S; S.init(MTOK, LDH - 256, G, opqi(blk));
            pg8::EpiH E{Hb, LDH, ROPEH, ROPEI, SX, (const float*)(SWMAX + SWM_WIN + L * LDH), SWMAX + SWM_VMAX + 2 * L};
            pg8::gemm_phase<pg8::EpiH, pg8::StaticOrder, true, true>(lds + RING_OFF, g, S, E);
#ifdef MK_PROBE_NULLEPI
            { pg8::Gemm g2{opq(XQ), opq(WINQ + (size_t)L * LDH * DM), MTOK, LDH - 256, DM, DM}; pg8::StaticOrder S2; S2.init(MTOK, LDH - 256, G, opqi(blk));
#if MK_PROBE_NULLEPI == 2
              pg8::EpiDummyStoreI8 E2{(pg8::bf16_t*)SC}; pg8::gemm_phase<pg8::EpiDummyStoreI8, pg8::StaticOrder, true, true>(lds + RING_OFF, g2, S2, E2); }
#else
              pg8::EpiNullI8 E2; pg8::gemm_phase<pg8::EpiNullI8, pg8::StaticOrder, true, true>(lds + RING_OFF, g2, S2, E2); }
#endif
#endif
            }
            }
            SEAM(pb + 0);
        }
        if (PH_ON(1) && IN(pb + 1)) {
            const int tid = pg8::opqv(tid0), lane = tid & 63; (void)lane; unsigned char* ws = (unsigned char*)ldptr(PT, 20); (void)ws;
            for (int rep_ = REPN(pb + 1); rep_ > 0; --rep_) {
            if (!MK_SKIP_MIXER) {
#ifndef MK_REP_SUB
#define MK_REP_SUB 0
#endif
#ifndef MK_NO_IDX
            for (int r2 = ((MK_REP_SUB) & 1) ? 2 : 1; r2 > 0; --r2)
            for (int u = blk; u < 256; u += G) { const int b = u >> 6, cp = (u >> 1) & 31, h2 = u & 1;
                for (int k2 = 0; k2 < 2; ++k2) { const int c = k2 ? 63 - cp : cp;
                    score_task(lds + RING_OFF, Hb, SC, b, c, h2, wave, tid);
                    VM_WAIT();
                    for (int pp = 0; pp < 2; ++pp) select_task(SC, (unsigned*)MASK, b, c, 16 * h2 + 2 * wave + pp, lane); } }
#endif
#ifndef MK_NO_SB
            const float vmB = __uint_as_float(__builtin_amdgcn_readfirstlane(SWMAX[SWM_VMAX + 2 * L + 1])); const float oinvB = vmB > 0.f ? 127.0f / vmB : 0.f;
            for (int r2 = ((MK_REP_SUB) & 2) ? 2 : 1; r2 > 0; --r2)
            for (int u = blk; u < 256; u += G) { const int uu = (G == 256) ? (((u & 7) << 5) | (u >> 3)) : u;
                const int b = uu >> 6, h = (uu >> 3) & 7, s = uu & 7;
                for (int k2 = 0; k2 < 2; ++k2) att::attn_unit<1>(lds + RING_OFF, Hb, MASK, OB, oinvB, b, h, k2 ? 15 - s : s); }
#endif
            }
            }
            SEAM(pb + 1);
        }
        if (PH_ON(3) && IN(pb + 3)) {
            const int tid = pg8::opqv(tid0), lane = tid & 63; (void)lane; unsigned char* ws = (unsigned char*)ldptr(PT, 20); (void)ws;
            for (int rep_ = REPN(pb + 3); rep_ > 0; --rep_) {
            if (!MK_SKIP_MIXER) {
            const float vmA = __uint_as_float(__builtin_amdgcn_readfirstlane(SWMAX[SWM_VMAX + 2 * L])); const float oinvA = vmA > 0.f ? 127.0f / vmA : 0.f;
            for (int u = blk; u < 256; u += G) { const int uu = (G == 256) ? (((u & 7) << 5) | (u >> 3)) : u;
                const int b = uu >> 6, h = (uu >> 3) & 7, s = uu & 7;
                for (int k2 = 0; k2 < 2; ++k2) att::sparse_unit_p(lds + RING_OFF, Hb, MASK, OA, oinvA, b, h, k2 ? 15 - s : s); }
            }
            }
            SEAM(pb + 3);
        }
        if (PH_ON(4) && IN(pb + 4)) {
            const int tid = pg8::opqv(tid0), lane = tid & 63; (void)lane; unsigned char* ws = (unsigned char*)ldptr(PT, 20); (void)ws;
            for (int rep_ = REPN(pb + 4); rep_ > 0; --rep_) {
            if (!MK_SKIP_MIXER) {
            { pg8::Gemm g{opq(OA), opq(PAQ + (size_t)L * DM * 1024), MTOK, DM, 1024, 1024}; pg8::StaticOrder S; S.init(MTOK, DM, G, opqi(blk));
              pg8::EpiGate<0> E{MG, DM, Hb + C_GA, LDH, (const float*)(SWMAX + SWM_VMAX + 2 * L), (const float*)(SWMAX + SWM_PA + L * DM)};
              pg8::gemm_phase<pg8::EpiGate<0>, pg8::StaticOrder, true, true>(lds + RING_OFF, g, S, E); }
            { pg8::Gemm g{opq(OB), opq(PBQ + (size_t)L * DM * 1024), MTOK, DM, 1024, 1024}; pg8::StaticOrder S; S.init(MTOK, DM, G, opqi(blk));
              pg8::EpiGate<1> E{MG, DM, Hb + C_GB, LDH, (const float*)(SWMAX + SWM_VMAX + 2 * L + 1), (const float*)(SWMAX + SWM_PB + L * DM)};
              pg8::gemm_phase<pg8::EpiGate<1>, pg8::StaticOrder, true, true>(lds + RING_OFF, g, S, E); }
            }
            }
            SEAM(pb + 4);
        }
        if (PH_ON(5) && IN(pb + 5)) {
            const int tid = pg8::opqv(tid0), lane = tid & 63; (void)lane; unsigned char* ws = (unsigned char*)ldptr(PT, 20); (void)ws;
            for (int rep_ = REPN(pb + 5); rep_ > 0; --rep_) {
            if (!MK_SKIP_MIXER) {
            pg8::Gemm g{opq(MG), opq(WOUT_T + (size_t)L * DM * DM), MTOK, DM, 2 * DM, 2 * DM}; pg8::StaticOrder S; S.init(MTOK, DM, G, opqi(blk));
            pg8::EpiResid<L == 0> E{PT, 21 * L, 21, 22, 2 + 15 * L, 3 + 15 * L, DM, DN_ALPHA};
            pg8::gemm_phase<pg8::EpiResid<L == 0>, pg8::StaticOrder, true, true>(lds + RING_OFF, g, S, E);
            }
            }
            SEAM(pb + 5);
        }
        if (PH_ON(6) && IN(pb + 6)) {
            const int tid = pg8::opqv(tid0), lane = tid & 63; (void)lane; unsigned char* ws = (unsigned char*)ldptr(PT, 20); (void)ws;
            for (int rep_ = REPN(pb + 6); rep_ > 0; --rep_) {
            LAS unsigned* cntw = (LAS unsigned*)(lds + RING_OFF);
            f32x4 gg[8], bb[8];
#pragma unroll
            for (int j = 0; j < 8; ++j) { gg[j] = *((const f32x4*)(((const float*)ldptr(PT, 8)) + L * DM) + lane + 64 * j); bb[j] = *((const f32x4*)(((const float*)ldptr(PT, 9)) + L * DM) + lane + 64 * j); }
            for (int rb = blk; rb < MTOK / 64; rb += G) {
                if (L == 1) { if (tid < 64) cntw[tid] = 0u;
                    for (int n = tid; n < 4096; n += NWAVES * 64) { const int k = n >> 1, hf = n & 1, ln_ = (k >> 2) & 63, j = k >> 8, q = k & 3;
                        *(LAS f32x4*)(lds + RING_OFF + 1024 + (((j * 8 + q * 2 + hf) * 64 + ln_) << 4)) = *((const f32x4*)ldptr(PT, 13) + n); }
                    LDS_WAIT(); __syncthreads(); }
                unsigned my_info = 0u; float my_g1 = 0.f;
                v2u nx[8];
                { const v2u* rp0 = (const v2u*)(XS + (size_t)(rb * 64 + wave * 8) * DM);
#pragma unroll
                  for (int j = 0; j < 8; ++j) nx[j] = rp0[lane + 64 * j]; }
                for (int i = 0; i < 8; ++i) {
                    const int m = rb * 64 + wave * 8 + i;
                    f32x4 v[8];
#pragma unroll
                    for (int j = 0; j < 8; ++j) v[j] = (f32x4){bflo(nx[j].x), bfhi(nx[j].x), bflo(nx[j].y), bfhi(nx[j].y)};
                    if (i + 1 < 8) { const v2u* rpn = (const v2u*)(XS + (size_t)(m + 1) * DM);
#pragma unroll
                        for (int j = 0; j < 8; ++j) nx[j] = rpn[lane + 64 * j]; }
                    if (MK_SKIP_MIXER) {
#pragma unroll
                        for (int j = 0; j < 8; ++j) v[j] = v[j] * DN_ALPHA;
                    }
                    ln_regs_r(v, gg, bb, lane, STATS + 2 * m); store_row(v, nullptr, XQ + (size_t)m * DM, SX + m, lane);
                    if (L == 1) {
                        float lg[8];
#pragma unroll
                        for (int e = 0; e < 8; ++e) lg[e] = 0.f;
#pragma unroll
                        for (int j = 0; j < 8; ++j) { LAS const f32x4* rp = (LAS const f32x4*)(lds + RING_OFF + 1024) + (j * 8) * 64 + lane;
#pragma unroll
                            for (int q = 0; q < 4; ++q) { const f32x4 r0 = rp[(2 * q) * 64], r1 = rp[(2 * q + 1) * 64]; const float xv = v[j][q];
                                lg[0] = fmaf(xv, r0.x, lg[0]); lg[1] = fmaf(xv, r0.y, lg[1]); lg[2] = fmaf(xv, r0.z, lg[2]); lg[3] = fmaf(xv, r0.w, lg[3]);
                                lg[4] = fmaf(xv, r1.x, lg[4]); lg[5] = fmaf(xv, r1.y, lg[5]); lg[6] = fmaf(xv, r1.z, lg[6]); lg[7] = fmaf(xv, r1.w, lg[7]); } }
#pragma unroll
                        for (int e = 0; e < 8; ++e) lg[e] = wave_sum(lg[e]);
                        int e1 = 0; float v1 = lg[0];
#pragma unroll
                        for (int e = 1; e < 8; ++e) if (lg[e] > v1) { v1 = lg[e]; e1 = e; }
                        int e2 = -1; float v2 = -__builtin_inff();
#pragma unroll
                        for (int e = 0; e < 8; ++e) if (e != e1 && lg[e] > v2) { v2 = lg[e]; e2 = e; }
                        const float g1 = 1.0f / (1.0f + __expf(v2 - v1));
                        if (lane == 0) { const unsigned r1 = cntw[wave * 8 + e1]; cntw[wave * 8 + e1] = r1 + 1u; const unsigned r2 = cntw[wave * 8 + e2]; cntw[wave * 8 + e2] = r2 + 1u;
                            my_info = (unsigned)e1 | ((unsigned)e2 << 4) | (r1 << 8) | (r2 << 16); my_g1 = g1; }
                        const unsigned inf_b = __builtin_amdgcn_readfirstlane(my_info); const float g_b = __uint_as_float(__builtin_amdgcn_readfirstlane(__float_as_uint(my_g1)));
                        if (lane == 8 + i) { my_info = inf_b; my_g1 = g_b; }
                    }
                }
                if (L == 1) {
                    LDS_WAIT(); __syncthreads();
                    if (lane >= 8 && lane < 16) { const int i = lane - 8; const int m = rb * 64 + wave * 8 + i;
                        const int e1 = my_info & 15, e2 = (my_info >> 4) & 15; unsigned r1 = (my_info >> 8) & 255u, r2 = (my_info >> 16) & 255u;
                        for (int w2 = 0; w2 < wave; ++w2) { r1 += cntw[w2 * 8 + e1]; r2 += cntw[w2 * 8 + e2]; }
                        v4u rec; rec.x = (unsigned)e1 | ((unsigned)e2 << 4) | (r1 << 8) | (r2 << 16); rec.y = __float_as_uint(my_g1); rec.z = 0u; rec.w = 0u;
                        *(v4u*)(TOK + (size_t)m * 4) = rec; }
                    if (tid < 8) { unsigned c = 0u; for (int w2 = 0; w2 < 8; ++w2) c += cntw[w2 * 8 + tid]; BCNT[rb * 8 + tid] = c; }
                    __syncthreads();
                }
            }
            }
            SEAM(pb + 6);
        }
        if (L == 0) {
            if (PH_ON(7) && IN(pb + 7)) {
            const int tid = pg8::opqv(tid0), lane = tid & 63; (void)lane; unsigned char* ws = (unsigned char*)ldptr(PT, 20); (void)ws;
            for (int rep_ = REPN(pb + 7); rep_ > 0; --rep_) {
                pg8::Gemm g{opq(XQ), opq(FGUQ), MTOK, 2 * DFF, DM, DM}; pg8::StaticOrder S; S.init(MTOK, 2 * DFF, G, opqi(blk));
                pg8::EpiSwiglu E{HDb, DFF, SX, (const float*)(SWMAX + SWM_FGU)};
                pg8::gemm_phase<pg8::EpiSwiglu, pg8::StaticOrder, true, true>(lds + RING_OFF, g, S, E);
            }
                SEAM(pb + 7);
            }
            if (PH_ON(8) && IN(pb + 8)) {
            const int tid = pg8::opqv(tid0), lane = tid & 63; (void)lane; unsigned char* ws = (unsigned char*)ldptr(PT, 20); (void)ws;
            for (int rep_ = REPN(pb + 8); rep_ > 0; --rep_) {
                pg8::Gemm g{opq(HDb), opq(FD_T), MTOK, DM, 2 * DFF, 2 * DFF}; pg8::StaticOrder S; S.init(MTOK, DM, G, opqi(blk));
                pg8::EpiResid<false> E{PT, 21, 21, 22, 8, 9, DM, DN_ALPHA};
                pg8::gemm_phase<pg8::EpiResid<false>, pg8::StaticOrder, true, true>(lds + RING_OFF, g, S, E);
            }
                SEAM(pb + 8);
            }
            if (PH_ON(9) && IN(pb + 9)) {
            const int tid = pg8::opqv(tid0), lane = tid & 63; (void)lane; unsigned char* ws = (unsigned char*)ldptr(PT, 20); (void)ws;
            for (int rep_ = REPN(pb + 9); rep_ > 0; --rep_) {
                f32x4 gg[8], bb[8];
#pragma unroll
                for (int j = 0; j < 8; ++j) { gg[j] = *((const f32x4*)ldptr(PT, 17) + lane + 64 * j); bb[j] = *((const f32x4*)ldptr(PT, 18) + lane + 64 * j); }
                v2u nx[8];
                if (gw < MTOK) { const v2u* rp0 = (const v2u*)(XS + (size_t)gw * DM);
#pragma unroll
                    for (int j = 0; j < 8; ++j) nx[j] = rp0[lane + 64 * j]; }
                for (int m = gw; m < MTOK; m += NGW) { f32x4 v[8];
#pragma unroll
                    for (int j = 0; j < 8; ++j) v[j] = (f32x4){bflo(nx[j].x), bfhi(nx[j].x), bflo(nx[j].y), bfhi(nx[j].y)};
                    if (m + NGW < MTOK) { const v2u* rpn = (const v2u*)(XS + (size_t)(m + NGW) * DM);
#pragma unroll
                        for (int j = 0; j < 8; ++j) nx[j] = rpn[lane + 64 * j]; }
                    ln_regs_r(v, gg, bb, lane, STATS + 2 * m); store_row(v, nullptr, XQ + (size_t)m * DM, SX + m, lane); }
            }
                SEAM(pb + 9);
            }
        } else {
            if (PH_ON(7) && IN(pb + 7)) {
            const int tid = pg8::opqv(tid0), lane = tid & 63; (void)lane; unsigned char* ws = (unsigned char*)ldptr(PT, 20); (void)ws;
            for (int rep_ = REPN(pb + 7); rep_ > 0; --rep_) {
                LAS unsigned* red = (LAS unsigned*)(lds + RING_OFF);
                for (int rb = blk; rb < MTOK / 64; rb += G) {
                    if (tid < 16) red[tid] = 0u;
                    __syncthreads();
                    if (tid < 256) { const v4u c0 = *(const v4u*)(BCNT + tid * 8), c1 = *(const v4u*)(BCNT + tid * 8 + 4); const unsigned cc[8] = {c0.x, c0.y, c0.z, c0.w, c1.x, c1.y, c1.z, c1.w};
#pragma unroll
                        for (int e = 0; e < 8; ++e) { atomicAdd((unsigned*)&red[e], cc[e]); if (tid < rb) atomicAdd((unsigned*)&red[8 + e], cc[e]); } }
                    __syncthreads();
                    unsigned toff[9]; toff[0] = 0u;
#pragma unroll
                    for (int e = 0; e < 8; ++e) toff[e + 1] = toff[e] + ((red[e] + 255u) >> 8);
                    if (rb == 0 && tid < 9) { unsigned tv = 0u;
#pragma unroll
                        for (int e = 0; e < 9; ++e) tv = (tid == e) ? toff[e] : tv;
                        META[tid] = tv; }
                    if (lane < 8) {
                        const int m = rb * 64 + wave * 8 + lane; v4u rec = *(const v4u*)(TOK + (size_t)m * 4);
                        const int e1 = rec.x & 15, e2 = (rec.x >> 4) & 15; const unsigned r1 = (rec.x >> 8) & 255u, r2 = (rec.x >> 16) & 255u;
                        unsigned s1 = 0u, s2 = 0u;
#pragma unroll
                        for (int e = 0; e < 8; ++e) { const unsigned base = toff[e] * 256u + red[8 + e]; s1 = (e == e1) ? base + r1 : s1; s2 = (e == e2) ? base + r2 : s2; }
                        rec.z = s1; rec.w = s2; *(v4u*)(TOK + (size_t)m * 4) = rec;
                        MISC[16 + wave * 16 + lane * 2] = s1; MISC[16 + wave * 16 + lane * 2 + 1] = s2; }
                    LDS_WAIT();
                    { v4u tq[8][2]; float sxv[8];
#pragma unroll
                      for (int i = 0; i < 8; ++i) { const int m = rb * 64 + wave * 8 + i; const v4u* src = (const v4u*)(XQ + (size_t)m * DM); tq[i][0] = src[lane]; tq[i][1] = src[lane + 64]; sxv[i] = SX[m]; }
#pragma unroll
                      for (int i = 0; i < 8; ++i) { const unsigned s1 = MISC[16 + wave * 16 + i * 2], s2 = MISC[16 + wave * 16 + i * 2 + 1];
                        v4u* d1 = (v4u*)(XGQ + (size_t)s1 * DM); v4u* d2 = (v4u*)(XGQ + (size_t)s2 * DM);
                        d1[lane] = tq[i][0]; d1[lane + 64] = tq[i][1]; d2[lane] = tq[i][0]; d2[lane + 64] = tq[i][1];
                        if (lane == 0) { SXG[s1] = sxv[i]; SXG[s2] = sxv[i]; } } }
                    __syncthreads();
                }
            }
                SEAM(pb + 7);
            }
            if (PH_ON(8) && IN(pb + 8)) {
            const int tid = pg8::opqv(tid0), lane = tid & 63; (void)lane; unsigned char* ws = (unsigned char*)ldptr(PT, 20); (void)ws;
            for (int rep_ = REPN(pb + 8); rep_ > 0; --rep_) {
                pg8::GroupedOrder S; S.nN = 2 * DEXP / 256; S.G = G; S.c = opqi(blk);
#pragma unroll
                for (int e = 0; e < 9; ++e) S.toff[e] = (int)__builtin_amdgcn_readfirstlane(META[e]);
                S.nM = S.toff[8]; S.nwg = S.nM * S.nN;
                pg8::Gemm g{opq(XGQ), opq(MGUQ), S.nM * 256, 2 * DEXP, DM, DM};
                pg8::EpiSwiglu E{HDM, DEXP, SXG, (const float*)(SWMAX + SWM_MGU)};
                pg8::gemm_phase<pg8::EpiSwiglu, pg8::GroupedOrder, true, true>(lds + RING_OFF, g, S, E);
            }
                SEAM(pb + 8);
            }
            if (PH_ON(9) && IN(pb + 9)) {
            const int tid = pg8::opqv(tid0), lane = tid & 63; (void)lane; unsigned char* ws = (unsigned char*)ldptr(PT, 20); (void)ws;
            for (int rep_ = REPN(pb + 9); rep_ > 0; --rep_) {
                int toffv[9];
#pragma unroll
                for (int e = 0; e < 9; ++e) toffv[e] = (int)__builtin_amdgcn_readfirstlane(META[e]);
                const int nMt = toffv[8], nr = nMt & 31, nMf = nMt - nr;
                { pg8::GroupedOrder S; S.nN = DM / 256; S.G = G; S.c = opqi(blk);
#pragma unroll
                  for (int e = 0; e < 9; ++e) S.toff[e] = toffv[e];
                  S.nM = nMf; S.nwg = S.nM * S.nN;
                  pg8::Gemm g{opq(HDM), opq(MD_T), nMf * 256, DM, 2 * DEXP, 2 * DEXP};
                  pg8::EpiStoreBf16 E{SO, DM};
                  pg8::gemm_phase<pg8::EpiStoreBf16, pg8::GroupedOrder, true, true>(lds + RING_OFF, g, S, E); }
                if (nr > 0) { pg8::SplitOrder S; S.pm0 = nMf; S.nr = nr; S.nN = DM / 256; S.nch = 7; S.kbytes = 2 * 1024; S.nwg = nr * (DM / 256) * 7; S.G = G; S.c = opqi(blk);
#pragma unroll
                  for (int e = 0; e < 9; ++e) S.toff[e] = toffv[e];
                  pg8::Gemm g{opq(HDM), opq(MD_T), nMt * 256, DM, 2 * DEXP, 2 * 1024};
                  pg8::EpiPartialF32 E{PART, DM};
                  pg8::gemm_phase<pg8::EpiPartialF32, pg8::SplitOrder, true, true>(lds + RING_OFF, g, S, E); }
            }
                SEAM(pb + 9);
            }
            if (PH_ON(10) && IN(pb + 10)) {
            const int tid = pg8::opqv(tid0), lane = tid & 63; (void)lane; unsigned char* ws = (unsigned char*)ldptr(PT, 20); (void)ws;
            for (int rep_ = REPN(pb + 10); rep_ > 0; --rep_) {
                const int nMt10 = (int)__builtin_amdgcn_readfirstlane(META[8]); const int split0 = (nMt10 - (nMt10 & 31)) * 256;
                v4u recA = (v4u){0u, 0u, 0u, 0u}, recB = recA;
                v2u nx[8], np1[8], np2[8];
#pragma unroll
                for (int j = 0; j < 8; ++j) { nx[j] = (v2u){0u, 0u}; np1[j] = (v2u){0u, 0u}; np2[j] = (v2u){0u, 0u}; }
#define CMB_ROWS(M_, REC_) do { \
                    { const v2u* xp_ = (const v2u*)(XS + (size_t)(M_) * DM); \
                      _Pragma("unroll") for (int j = 0; j < 8; ++j) nx[j] = xp_[lane + 64 * j]; } \
                    _Pragma("unroll") for (int j = 0; j < 8; ++j) { np1[j] = (v2u){0u, 0u}; np2[j] = (v2u){0u, 0u}; } \
                    if ((int)(REC_).z < split0) { const v2u* sp_ = (const v2u*)(SO + (size_t)(REC_).z * DM); \
                        _Pragma("unroll") for (int j = 0; j < 8; ++j) np1[j] = sp_[lane + 64 * j]; } \
                    if ((int)(REC_).w < split0) { const v2u* sp_ = (const v2u*)(SO + (size_t)(REC_).w * DM); \
                        _Pragma("unroll") for (int j = 0; j < 8; ++j) np2[j] = sp_[lane + 64 * j]; } } while (0)
                if (gw < MTOK) { recB = *(const v4u*)(TOK + (size_t)gw * 4); CMB_ROWS(gw, recB); }
                if (gw + NGW < MTOK) recA = *(const v4u*)(TOK + (size_t)(gw + NGW) * 4);
                for (int m = gw; m < MTOK; m += NGW) {
                    const v4u rec = recB; const float g1 = __uint_as_float(rec.y), g2 = 1.0f - g1;
                    f32x4 v[8]; v2u p1[8], p2[8];
#pragma unroll
                    for (int j = 0; j < 8; ++j) { v[j] = (f32x4){bflo(nx[j].x), bfhi(nx[j].x), bflo(nx[j].y), bfhi(nx[j].y)}; p1[j] = np1[j]; p2[j] = np2[j]; }
                    const bool s1b = (int)rec.z < split0, s2b = (int)rec.w < split0;
                    recB = recA;
                    if (m + NGW < MTOK) CMB_ROWS(m + NGW, recB);
                    if (m + 2 * NGW < MTOK) recA = *(const v4u*)(TOK + (size_t)(m + 2 * NGW) * 4);
                    ln_regs(v, ((const float*)ldptr(PT, 8)) + DM, ((const float*)ldptr(PT, 9)) + DM, lane);
#pragma unroll
                    for (int j = 0; j < 8; ++j) { v[j] = v[j] * DN_ALPHA;
                        v[j].x += g1 * bflo(p1[j].x) + g2 * bflo(p2[j].x); v[j].y += g1 * bfhi(p1[j].x) + g2 * bfhi(p2[j].x); v[j].z += g1 * bflo(p1[j].y) + g2 * bflo(p2[j].y); v[j].w += g1 * bfhi(p1[j].y) + g2 * bfhi(p2[j].y); }
#pragma unroll
                    for (int k2 = 0; k2 < 2; ++k2) { const unsigned slot = k2 ? rec.w : rec.z; const float gk = k2 ? g2 : g1; const bool sb = k2 ? s2b : s1b;
                        if (!sb) { const float* pp = PART + (size_t)((int)slot - split0) * DM;
#pragma unroll 1
                            for (int kch = 0; kch < 7; ++kch) {
#pragma unroll
                                for (int j = 0; j < 8; ++j) v[j] += *((const f32x4*)(pp + (size_t)kch * 2048 * DM) + lane + 64 * j) * gk; } } }
                    ln_regs(v, ((const float*)ldptr(PT, 17)) + DM, ((const float*)ldptr(PT, 18)) + DM, lane); store_row(v, ((float*)ldptr(PT, 19)) + (size_t)m * DM, nullptr, nullptr, lane);
                }
#undef CMB_ROWS
            }
            }
        }
    }
    {
        constexpr int L = 1;
        const int pb = PRO_PH + PH_PER_LAYER * L;
        if (PH_ON(0) && IN(pb + 0)) {
            const int tid = pg8::opqv(tid0), lane = tid & 63; (void)lane; unsigned char* ws = (unsigned char*)ldptr(PT, 20); (void)ws;
            for (int rep_ = REPN(pb + 0); rep_ > 0; --rep_) {
            if (!MK_SKIP_MIXER) {
            for (int u = blk; u < 256; u += G) kiwi_task(lds + RING_OFF, XQ, WINQ + ((size_t)L * LDH + C_KI) * DM, SX, (const float*)(SWMAX + SWM_WIN + L * LDH), ROPEI, Hb, 64 * u, wave, tid);
            pg8::Gemm g{opq(XQ), opq(WINQ + (size_t)L * LDH * DM), MTOK, LDH - 256, DM, DM}; pg8::StaticOrder S; S.init(MTOK, LDH - 256, G, opqi(blk));
            pg8::EpiH E{Hb, LDH, ROPEH, ROPEI, SX, (const float*)(SWMAX + SWM_WIN + L * LDH), SWMAX + SWM_VMAX + 2 * L};
            pg8::gemm_phase<pg8::EpiH, pg8::StaticOrder, true, true>(lds + RING_OFF, g, S, E);
#ifdef MK_PROBE_NULLEPI
            { pg8::Gemm g2{opq(XQ), opq(WINQ + (size_t)L * LDH * DM), MTOK, LDH - 256, DM, DM}; pg8::StaticOrder S2; S2.init(MTOK, LDH - 256, G, opqi(blk));
#if MK_PROBE_NULLEPI == 2
              pg8::EpiDummyStoreI8 E2{(pg8::bf16_t*)SC}; pg8::gemm_phase<pg8::EpiDummyStoreI8, pg8::StaticOrder, true, true>(lds + RING_OFF, g2, S2, E2); }
#else
              pg8::EpiNullI8 E2; pg8::gemm_phase<pg8::EpiNullI8, pg8::StaticOrder, true, true>(lds + RING_OFF, g2, S2, E2); }
#endif
#endif
            }
            }
            SEAM(pb + 0);
        }
        if (PH_ON(1) && IN(pb + 1)) {
            const int tid = pg8::opqv(tid0), lane = tid & 63; (void)lane; unsigned char* ws = (unsigned char*)ldptr(PT, 20); (void)ws;
            for (int rep_ = REPN(pb + 1); rep_ > 0; --rep_) {
            if (!MK_SKIP_MIXER) {
#ifndef MK_REP_SUB
#define MK_REP_SUB 0
#endif
#ifndef MK_NO_IDX
            for (int r2 = ((MK_REP_SUB) & 1) ? 2 : 1; r2 > 0; --r2)
            for (int u = blk; u < 256; u += G) { const int b = u >> 6, cp = (u >> 1) & 31, h2 = u & 1;
                for (int k2 = 0; k2 < 2; ++k2) { const int c = k2 ? 63 - cp : cp;
                    score_task(lds + RING_OFF, Hb, SC, b, c, h2, wave, tid);
                    VM_WAIT();
                    for (int pp = 0; pp < 2; ++pp) select_task(SC, (unsigned*)MASK, b, c, 16 * h2 + 2 * wave + pp, lane); } }
#endif
#ifndef MK_NO_SB
            const float vmB = __uint_as_float(__builtin_amdgcn_readfirstlane(SWMAX[SWM_VMAX + 2 * L + 1])); const float oinvB = vmB > 0.f ? 127.0f / vmB : 0.f;
            for (int r2 = ((MK_REP_SUB) & 2) ? 2 : 1; r2 > 0; --r2)
            for (int u = blk; u < 256; u += G) { const int uu = (G == 256) ? (((u & 7) << 5) | (u >> 3)) : u;
                const int b = uu >> 6, h = (uu >> 3) & 7, s = uu & 7;
                for (int k2 = 0; k2 < 2; ++k2) att::attn_unit<1>(lds + RING_OFF, Hb, MASK, OB, oinvB, b, h, k2 ? 15 - s : s); }
#endif
            }
            }
            SEAM(pb + 1);
        }
        if (PH_ON(3) && IN(pb + 3)) {
            const int tid = pg8::opqv(tid0), lane = tid & 63; (void)lane; unsigned char* ws = (unsigned char*)ldptr(PT, 20); (void)ws;
            for (int rep_ = REPN(pb + 3); rep_ > 0; --rep_) {
            if (!MK_SKIP_MIXER) {
            const float vmA = __uint_as_float(__builtin_amdgcn_readfirstlane(SWMAX[SWM_VMAX + 2 * L])); const float oinvA = vmA > 0.f ? 127.0f / vmA : 0.f;
            for (int u = blk; u < 256; u += G) { const int uu = (G == 256) ? (((u & 7) << 5) | (u >> 3)) : u;
                const int b = uu >> 6, h = (uu >> 3) & 7, s = uu & 7;
                for (int k2 = 0; k2 < 2; ++k2) att::sparse_unit_p(lds + RING_OFF, Hb, MASK, OA, oinvA, b, h, k2 ? 15 - s : s); }
            }
            }
            SEAM(pb + 3);
        }
        if (PH_ON(4) && IN(pb + 4)) {
            const int tid = pg8::opqv(tid0), lane = tid & 63; (void)lane; unsigned char* ws = (unsigned char*)ldptr(PT, 20); (void)ws;
            for (int rep_ = REPN(pb + 4); rep_ > 0; --rep_) {
            if (!MK_SKIP_MIXER) {
            { pg8::Gemm g{opq(OA), opq(PAQ + (size_t)L * DM * 1024), MTOK, DM, 1024, 1024}; pg8::StaticOrder S; S.init(MTOK, DM, G, opqi(blk));
              pg8::EpiGate<0> E{MG, DM, Hb + C_GA, LDH, (const float*)(SWMAX + SWM_VMAX + 2 * L), (const float*)(SWMAX + SWM_PA + L * DM)};
              pg8::gemm_phase<pg8::EpiGate<0>, pg8::StaticOrder, true, true>(lds + RING_OFF, g, S, E); }
            { pg8::Gemm g{opq(OB), opq(PBQ + (size_t)L * DM * 1024), MTOK, DM, 1024, 1024}; pg8::StaticOrder S; S.init(MTOK, DM, G, opqi(blk));
              pg8::EpiGate<1> E{MG, DM, Hb + C_GB, LDH, (const float*)(SWMAX + SWM_VMAX + 2 * L + 1), (const float*)(SWMAX + SWM_PB + L * DM)};
              pg8::gemm_phase<pg8::EpiGate<1>, pg8::StaticOrder, true, true>(lds + RING_OFF, g, S, E); }
            }
            }
            SEAM(pb + 4);
        }
        if (PH_ON(5) && IN(pb + 5)) {
            const int tid = pg8::opqv(tid0), lane = tid & 63; (void)lane; unsigned char* ws = (unsigned char*)ldptr(PT, 20); (void)ws;
            for (int rep_ = REPN(pb + 5); rep_ > 0; --rep_) {
            if (!MK_SKIP_MIXER) {
            pg8::Gemm g{opq(MG), opq(WOUT_T + (size_t)L * DM * DM), MTOK, DM, 2 * DM, 2 * DM}; pg8::StaticOrder S; S.init(MTOK, DM, G, opqi(blk));
            pg8::EpiResid<L == 0> E{PT, 21 * L, 21, 22, 2 + 15 * L, 3 + 15 * L, DM, DN_ALPHA};
            pg8::gemm_phase<pg8::EpiResid<L == 0>, pg8::StaticOrder, true, true>(lds + RING_OFF, g, S, E);
            }
            }
            SEAM(pb + 5);
        }
        if (PH_ON(6) && IN(pb + 6)) {
            const int tid = pg8::opqv(tid0), lane = tid & 63; (void)lane; unsigned char* ws = (unsigned char*)ldptr(PT, 20); (void)ws;
            for (int rep_ = REPN(pb + 6); rep_ > 0; --rep_) {
            LAS unsigned* cntw = (LAS unsigned*)(lds + RING_OFF);
            f32x4 gg[8], bb[8];
#pragma unroll
            for (int j = 0; j < 8; ++j) { gg[j] = *((const f32x4*)(((const float*)ldptr(PT, 8)) + L * DM) + lane + 64 * j); bb[j] = *((const f32x4*)(((const float*)ldptr(PT, 9)) + L * DM) + lane + 64 * j); }
            for (int rb = blk; rb < MTOK / 64; rb += G) {
                if (L == 1) { if (tid < 64) cntw[tid] = 0u;
                    for (int n = tid; n < 4096; n += NWAVES * 64) { const int k = n >> 1, hf = n & 1, ln_ = (k >> 2) & 63, j = k >> 8, q = k & 3;
                        *(LAS f32x4*)(lds + RING_OFF + 1024 + (((j * 8 + q * 2 + hf) * 64 + ln_) << 4)) = *((const f32x4*)ldptr(PT, 13) + n); }
                    LDS_WAIT(); __syncthreads(); }
                unsigned my_info = 0u; float my_g1 = 0.f;
                v2u nx[8];
                { const v2u* rp0 = (const v2u*)(XS + (size_t)(rb * 64 + wave * 8) * DM);
#pragma unroll
                  for (int j = 0; j < 8; ++j) nx[j] = rp0[lane + 64 * j]; }
                for (int i = 0; i < 8; ++i) {
                    const int m = rb * 64 + wave * 8 + i;
                    f32x4 v[8];
#pragma unroll
                    for (int j = 0; j < 8; ++j) v[j] = (f32x4){bflo(nx[j].x), bfhi(nx[j].x), bflo(nx[j].y), bfhi(nx[j].y)};
                    if (i + 1 < 8) { const v2u* rpn = (const v2u*)(XS + (size_t)(m + 1) * DM);
#pragma unroll
                        for (int j = 0; j < 8; ++j) nx[j] = rpn[lane + 64 * j]; }
                    if (MK_SKIP_MIXER) {
#pragma unroll
                        for (int j = 0; j < 8; ++j) v[j] = v[j] * DN_ALPHA;
                    }
                    ln_regs_r(v, gg, bb, lane, STATS + 2 * m); store_row(v, nullptr, XQ + (size_t)m * DM, SX + m, lane);
                    if (L == 1) {
                        float lg[8];
#pragma unroll
                        for (int e = 0; e < 8; ++e) lg[e] = 0.f;
#pragma unroll
                        for (int j = 0; j < 8; ++j) { LAS const f32x4* rp = (LAS const f32x4*)(lds + RING_OFF + 1024) + (j * 8) * 64 + lane;
#pragma unroll
                            for (int q = 0; q < 4; ++q) { const f32x4 r0 = rp[(2 * q) * 64], r1 = rp[(2 * q + 1) * 64]; const float xv = v[j][q];
                                lg[0] = fmaf(xv, r0.x, lg[0]); lg[1] = fmaf(xv, r0.y, lg[1]); lg[2] = fmaf(xv, r0.z, lg[2]); lg[3] = fmaf(xv, r0.w, lg[3]);
                                lg[4] = fmaf(xv, r1.x, lg[4]); lg[5] = fmaf(xv, r1.y, lg[5]); lg[6] = fmaf(xv, r1.z, lg[6]); lg[7] = fmaf(xv, r1.w, lg[7]); } }
#pragma unroll
                        for (int e = 0; e < 8; ++e) lg[e] = wave_sum(lg[e]);
                        int e1 = 0; float v1 = lg[0];
#pragma unroll
                        for (int e = 1; e < 8; ++e) if (lg[e] > v1) { v1 = lg[e]; e1 = e; }
                        int e2 = -1; float v2 = -__builtin_inff();
#pragma unroll
                        for (int e = 0; e < 8; ++e) if (e != e1 && lg[e] > v2) { v2 = lg[e]; e2 = e; }
                        const float g1 = 1.0f / (1.0f + __expf(v2 - v1));
                        if (lane == 0) { const unsigned r1 = cntw[wave * 8 + e1]; cntw[wave * 8 + e1] = r1 + 1u; const unsigned r2 = cntw[wave * 8 + e2]; cntw[wave * 8 + e2] = r2 + 1u;
                            my_info = (unsigned)e1 | ((unsigned)e2 << 4) | (r1 << 8) | (r2 << 16); my_g1 = g1; }
                        const unsigned inf_b = __builtin_amdgcn_readfirstlane(my_info); const float g_b = __uint_as_float(__builtin_amdgcn_readfirstlane(__float_as_uint(my_g1)));
                        if (lane == 8 + i) { my_info = inf_b; my_g1 = g_b; }
                    }
                }
                if (L == 1) {
                    LDS_WAIT(); __syncthreads();
                    if (lane >= 8 && lane < 16) { const int i = lane - 8; const int m = rb * 64 + wave * 8 + i;
                        const int e1 = my_info & 15, e2 = (my_info >> 4) & 15; unsigned r1 = (my_info >> 8) & 255u, r2 = (my_info >> 16) & 255u;
                        for (int w2 = 0; w2 < wave; ++w2) { r1 += cntw[w2 * 8 + e1]; r2 += cntw[w2 * 8 + e2]; }
                        v4u rec; rec.x = (unsigned)e1 | ((unsigned)e2 << 4) | (r1 << 8) | (r2 << 16); rec.y = __float_as_uint(my_g1); rec.z = 0u; rec.w = 0u;
                        *(v4u*)(TOK + (size_t)m * 4) = rec; }
                    if (tid < 8) { unsigned c = 0u; for (int w2 = 0; w2 < 8; ++w2) c += cntw[w2 * 8 + tid]; BCNT[rb * 8 + tid] = c; }
                    __syncthreads();
                }
            }
            }
            SEAM(pb + 6);
        }
        if (L == 0) {
            if (PH_ON(7) && IN(pb + 7)) {
            const int tid = pg8::opqv(tid0), lane = tid & 63; (void)lane; unsigned char* ws = (unsigned char*)ldptr(PT, 20); (void)ws;
            for (int rep_ = REPN(pb + 7); rep_ > 0; --rep_) {
                pg8::Gemm g{opq(XQ), opq(FGUQ), MTOK, 2 * DFF, DM, DM}; pg8::StaticOrder S; S.init(MTOK, 2 * DFF, G, opqi(blk));
                pg8::EpiSwiglu E{HDb, DFF, SX, (const float*)(SWMAX + SWM_FGU)};
                pg8::gemm_phase<pg8::EpiSwiglu, pg8::StaticOrder, true, true>(lds + RING_OFF, g, S, E);
            }
                SEAM(pb + 7);
            }
            if (PH_ON(8) && IN(pb + 8)) {
            const int tid = pg8::opqv(tid0), lane = tid & 63; (void)lane; unsigned char* ws = (unsigned char*)ldptr(PT, 20); (void)ws;
            for (int rep_ = REPN(pb + 8); rep_ > 0; --rep_) {
                pg8::Gemm g{opq(HDb), opq(FD_T), MTOK, DM, 2 * DFF, 2 * DFF}; pg8::StaticOrder S; S.init(MTOK, DM, G, opqi(blk));
                pg8::EpiResid<false> E{PT, 21, 21, 22, 8, 9, DM, DN_ALPHA};
                pg8::gemm_phase<pg8::EpiResid<false>, pg8::StaticOrder, true, true>(lds + RING_OFF, g, S, E);
            }
                SEAM(pb + 8);
            }
            if (PH_ON(9) && IN(pb + 9)) {
            const int tid = pg8::opqv(tid0), lane = tid & 63; (void)lane; unsigned char* ws = (unsigned char*)ldptr(PT, 20); (void)ws;
            for (int rep_ = REPN(pb + 9); rep_ > 0; --rep_) {
                f32x4 gg[8], bb[8];
#pragma unroll
                for (int j = 0; j < 8; ++j) { gg[j] = *((const f32x4*)ldptr(PT, 17) + lane + 64 * j); bb[j] = *((const f32x4*)ldptr(PT, 18) + lane + 64 * j); }
                v2u nx[8];
                if (gw < MTOK) { const v2u* rp0 = (const v2u*)(XS + (size_t)gw * DM);
#pragma unroll
                    for (int j = 0; j < 8; ++j) nx[j] = rp0[lane + 64 * j]; }
                for (int m = gw; m < MTOK; m += NGW) { f32x4 v[8];
#pragma unroll
                    for (int j = 0; j < 8; ++j) v[j] = (f32x4){bflo(nx[j].x), bfhi(nx[j].x), bflo(nx[j].y), bfhi(nx[j].y)};
                    if (m + NGW < MTOK) { const v2u* rpn = (const v2u*)(XS + (size_t)(m + NGW) * DM);
#pragma unroll
                        for (int j = 0; j < 8; ++j) nx[j] = rpn[lane + 64 * j]; }
                    ln_regs_r(v, gg, bb, lane, STATS + 2 * m); store_row(v, nullptr, XQ + (size_t)m * DM, SX + m, lane); }
            }
                SEAM(pb + 9);
            }
        } else {
            if (PH_ON(7) && IN(pb + 7)) {
            const int tid = pg8::opqv(tid0), lane = tid & 63; (void)lane; unsigned char* ws = (unsigned char*)ldptr(PT, 20); (void)ws;
            for (int rep_ = REPN(pb + 7); rep_ > 0; --rep_) {
                LAS unsigned* red = (LAS unsigned*)(lds + RING_OFF);
                for (int rb = blk; rb < MTOK / 64; rb += G) {
                    if (tid < 16) red[tid] = 0u;
                    __syncthreads();
                    if (tid < 256) { const v4u c0 = *(const v4u*)(BCNT + tid * 8), c1 = *(const v4u*)(BCNT + tid * 8 + 4); const unsigned cc[8] = {c0.x, c0.y, c0.z, c0.w, c1.x, c1.y, c1.z, c1.w};
#pragma unroll
                        for (int e = 0; e < 8; ++e) { atomicAdd((unsigned*)&red[e], cc[e]); if (tid < rb) atomicAdd((unsigned*)&red[8 + e], cc[e]); } }
                    __syncthreads();
                    unsigned toff[9]; toff[0] = 0u;
#pragma unroll
                    for (int e = 0; e < 8; ++e) toff[e + 1] = toff[e] + ((red[e] + 255u) >> 8);
                    if (rb == 0 && tid < 9) { unsigned tv = 0u;
#pragma unroll
                        for (int e = 0; e < 9; ++e) tv = (tid == e) ? toff[e] : tv;
                        META[tid] = tv; }
                    if (lane < 8) {
                        const int m = rb * 64 + wave * 8 + lane; v4u rec = *(const v4u*)(TOK + (size_t)m * 4);
                        const int e1 = rec.x & 15, e2 = (rec.x >> 4) & 15; const unsigned r1 = (rec.x >> 8) & 255u, r2 = (rec.x >> 16) & 255u;
                        unsigned s1 = 0u, s2 = 0u;
#pragma unroll
                        for (int e = 0; e < 8; ++e) { const unsigned base = toff[e] * 256u + red[8 + e]; s1 = (e == e1) ? base + r1 : s1; s2 = (e == e2) ? base + r2 : s2; }
                        rec.z = s1; rec.w = s2; *(v4u*)(TOK + (size_t)m * 4) = rec;
                        MISC[16 + wave * 16 + lane * 2] = s1; MISC[16 + wave * 16 + lane * 2 + 1] = s2; }
                    LDS_WAIT();
                    { v4u tq[8][2]; float sxv[8];
#pragma unroll
                      for (int i = 0; i < 8; ++i) { const int m = rb * 64 + wave * 8 + i; const v4u* src = (const v4u*)(XQ + (size_t)m * DM); tq[i][0] = src[lane]; tq[i][1] = src[lane + 64]; sxv[i] = SX[m]; }
#pragma unroll
                      for (int i = 0; i < 8; ++i) { const unsigned s1 = MISC[16 + wave * 16 + i * 2], s2 = MISC[16 + wave * 16 + i * 2 + 1];
                        v4u* d1 = (v4u*)(XGQ + (size_t)s1 * DM); v4u* d2 = (v4u*)(XGQ + (size_t)s2 * DM);
                        d1[lane] = tq[i][0]; d1[lane + 64] = tq[i][1]; d2[lane] = tq[i][0]; d2[lane + 64] = tq[i][1];
                        if (lane == 0) { SXG[s1] = sxv[i]; SXG[s2] = sxv[i]; } } }
                    __syncthreads();
                }
            }
                SEAM(pb + 7);
            }
            if (PH_ON(8) && IN(pb + 8)) {
            const int tid = pg8::opqv(tid0), lane = tid & 63; (void)lane; unsigned char* ws = (unsigned char*)ldptr(PT, 20); (void)ws;
            for (int rep_ = REPN(pb + 8); rep_ > 0; --rep_) {
                pg8::GroupedOrder S; S.nN = 2 * DEXP / 256; S.G = G; S.c = opqi(blk);
#pragma unroll
                for (int e = 0; e < 9; ++e) S.toff[e] = (int)__builtin_amdgcn_readfirstlane(META[e]);
                S.nM = S.toff[8]; S.nwg = S.nM * S.nN;
                pg8::Gemm g{opq(XGQ), opq(MGUQ), S.nM * 256, 2 * DEXP, DM, DM};
                pg8::EpiSwiglu E{HDM, DEXP, SXG, (const float*)(SWMAX + SWM_MGU)};
                pg8::gemm_phase<pg8::EpiSwiglu, pg8::GroupedOrder, true, true>(lds + RING_OFF, g, S, E);
            }
                SEAM(pb + 8);
            }
            if (PH_ON(9) && IN(pb + 9)) {
            const int tid = pg8::opqv(tid0), lane = tid & 63; (void)lane; unsigned char* ws = (unsigned char*)ldptr(PT, 20); (void)ws;
            for (int rep_ = REPN(pb + 9); rep_ > 0; --rep_) {
                int toffv[9];
#pragma unroll
                for (int e = 0; e < 9; ++e) toffv[e] = (int)__builtin_amdgcn_readfirstlane(META[e]);
                const int nMt = toffv[8], nr = nMt & 31, nMf = nMt - nr;
                { pg8::GroupedOrder S; S.nN = DM / 256; S.G = G; S.c = opqi(blk);
#pragma unroll
                  for (int e = 0; e < 9; ++e) S.toff[e] = toffv[e];
                  S.nM = nMf; S.nwg = S.nM * S.nN;
                  pg8::Gemm g{opq(HDM), opq(MD_T), nMf * 256, DM, 2 * DEXP, 2 * DEXP};
                  pg8::EpiStoreBf16 E{SO, DM};
                  pg8::gemm_phase<pg8::EpiStoreBf16, pg8::GroupedOrder, true, true>(lds + RING_OFF, g, S, E); }
                if (nr > 0) { pg8::SplitOrder S; S.pm0 = nMf; S.nr = nr; S.nN = DM / 256; S.nch = 7; S.kbytes = 2 * 1024; S.nwg = nr * (DM / 256) * 7; S.G = G; S.c = opqi(blk);
#pragma unroll
                  for (int e = 0; e < 9; ++e) S.toff[e] = toffv[e];
                  pg8::Gemm g{opq(HDM), opq(MD_T), nMt * 256, DM, 2 * DEXP, 2 * 1024};
                  pg8::EpiPartialF32 E{PART, DM};
                  pg8::gemm_phase<pg8::EpiPartialF32, pg8::SplitOrder, true, true>(lds + RING_OFF, g, S, E); }
            }
                SEAM(pb + 9);
            }
            if (PH_ON(10) && IN(pb + 10)) {
            const int tid = pg8::opqv(tid0), lane = tid & 63; (void)lane; unsigned char* ws = (unsigned char*)ldptr(PT, 20); (void)ws;
            for (int rep_ = REPN(pb + 10); rep_ > 0; --rep_) {
                const int nMt10 = (int)__builtin_amdgcn_readfirstlane(META[8]); const int split0 = (nMt10 - (nMt10 & 31)) * 256;
                v4u recA = (v4u){0u, 0u, 0u, 0u}, recB = recA;
                v2u nx[8], np1[8], np2[8];
#pragma unroll
                for (int j = 0; j < 8; ++j) { nx[j] = (v2u){0u, 0u}; np1[j] = (v2u){0u, 0u}; np2[j] = (v2u){0u, 0u}; }
#define CMB_ROWS(M_, REC_) do { \
                    { const v2u* xp_ = (const v2u*)(XS + (size_t)(M_) * DM); \
                      _Pragma("unroll") for (int j = 0; j < 8; ++j) nx[j] = xp_[lane + 64 * j]; } \
                    _Pragma("unroll") for (int j = 0; j < 8; ++j) { np1[j] = (v2u){0u, 0u}; np2[j] = (v2u){0u, 0u}; } \
                    if ((int)(REC_).z < split0) { const v2u* sp_ = (const v2u*)(SO + (size_t)(REC_).z * DM); \
                        _Pragma("unroll") for (int j = 0; j < 8; ++j) np1[j] = sp_[lane + 64 * j]; } \
                    if ((int)(REC_).w < split0) { const v2u* sp_ = (const v2u*)(SO + (size_t)(REC_).w * DM); \
                        _Pragma("unroll") for (int j = 0; j < 8; ++j) np2[j] = sp_[lane + 64 * j]; } } while (0)
                if (gw < MTOK) { recB = *(const v4u*)(TOK + (size_t)gw * 4); CMB_ROWS(gw, recB); }
                if (gw + NGW < MTOK) recA = *(const v4u*)(TOK + (size_t)(gw + NGW) * 4);
                for (int m = gw; m < MTOK; m += NGW) {
                    const v4u rec = recB; const float g1 = __uint_as_float(rec.y), g2 = 1.0f - g1;
                    f32x4 v[8]; v2u p1[8], p2[8];
#pragma unroll
                    for (int j = 0; j < 8; ++j) { v[j] = (f32x4){bflo(nx[j].x), bfhi(nx[j].x), bflo(nx[j].y), bfhi(nx[j].y)}; p1[j] = np1[j]; p2[j] = np2[j]; }
                    const bool s1b = (int)rec.z < split0, s2b = (int)rec.w < split0;
                    recB = recA;
                    if (m + NGW < MTOK) CMB_ROWS(m + NGW, recB);
                    if (m + 2 * NGW < MTOK) recA = *(const v4u*)(TOK + (size_t)(m + 2 * NGW) * 4);
                    ln_regs(v, ((const float*)ldptr(PT, 8)) + DM, ((const float*)ldptr(PT, 9)) + DM, lane);
#pragma unroll
                    for (int j = 0; j < 8; ++j) { v[j] = v[j] * DN_ALPHA;
                        v[j].x += g1 * bflo(p1[j].x) + g2 * bflo(p2[j].x); v[j].y += g1 * bfhi(p1[j].x) + g2 * bfhi(p2[j].x); v[j].z += g1 * bflo(p1[j].y) + g2 * bflo(p2[j].y); v[j].w += g1 * bfhi(p1[j].y) + g2 * bfhi(p2[j].y); }
#pragma unroll
                    for (int k2 = 0; k2 < 2; ++k2) { const unsigned slot = k2 ? rec.w : rec.z; const float gk = k2 ? g2 : g1; const bool sb = k2 ? s2b : s1b;
                        if (!sb) { const float* pp = PART + (size_t)((int)slot - split0) * DM;
#pragma unroll 1
                            for (int kch = 0; kch < 7; ++kch) {
#pragma unroll
                                for (int j = 0; j < 8; ++j) v[j] += *((const f32x4*)(pp + (size_t)kch * 2048 * DM) + lane + 64 * j) * gk; } } }
                    ln_regs(v, ((const float*)ldptr(PT, 17)) + DM, ((const float*)ldptr(PT, 18)) + DM, lane); store_row(v, ((float*)ldptr(PT, 19)) + (size_t)m * DM, nullptr, nullptr, lane);
                }
#undef CMB_ROWS
            }
            }
        }
    }
#undef IN
#undef SEAM
#undef WINQ
#undef PAQ
#undef PBQ
#undef WOUT_T
#undef FGUQ
#undef FD_T
#undef MGUQ
#undef MD_T
#undef XS
#undef XQ
#undef SX
#undef STATS
#undef SWMAX
#undef ROPEH
#undef ROPEI
#undef TOK
#undef BCNT
#undef META
#undef Hb
#undef OA
#undef OB
#undef MG
#undef MASK
#undef SC
#undef HDb
#undef XGQ
#undef SO
#undef HDM
#undef SXG
#undef PART
}

extern "C" void kernel_launch(void* const* d_in, const int* in_sizes, int n_in, void* d_out, int out_size, void* d_ws, size_t ws_size, hipStream_t stream) {
    static int grid = 0;
    if (grid == 0) {
        if (n_in != 19 || out_size != MTOK * DM || ws_size < WS_END) { fprintf(stderr, "kernel_launch: unexpected shapes (n_in %d out %d ws %zu need %zu)\n", n_in, out_size, ws_size, (size_t)WS_END); grid = -1; return; }
        int dev = 0, cus = 0, per_cu = 0;
        if (hipGetDevice(&dev) != hipSuccess || hipDeviceGetAttribute(&cus, hipDeviceAttributeMultiprocessorCount, dev) != hipSuccess) { grid = -1; return; }
        if (hipFuncSetAttribute((const void*)fwd_kernel, hipFuncAttributeMaxDynamicSharedMemorySize, LDS_BYTES) != hipSuccess) { fprintf(stderr, "kernel_launch: hipFuncSetAttribute failed\n"); grid = -1; return; }
        if (hipOccupancyMaxActiveBlocksPerMultiprocessor(&per_cu, (const void*)fwd_kernel, NWAVES * 64, LDS_BYTES) != hipSuccess || per_cu < 1)
            fprintf(stderr, "kernel_launch: occupancy query reports %d workgroups per CU\n", per_cu);
        (void)hipGetLastError();
        grid = cus < 256 ? cus : 256;
    }
    if (grid < 0) return;
    (void)hipMemsetAsync((char*)d_ws + WS_CTL, 0, CTL_ZERO_BYTES, stream);
    Ptrs a{};
    a.x = (const float*)d_in[0]; a.pos = (const int*)d_in[1]; a.ln_in_g = (const float*)d_in[2]; a.ln_in_b = (const float*)d_in[3]; a.w_in = (const float*)d_in[4];
    a.w_proj_a = (const float*)d_in[5]; a.w_proj_b = (const float*)d_in[6]; a.w_out = (const float*)d_in[7]; a.ln_mix_g = (const float*)d_in[8]; a.ln_mix_b = (const float*)d_in[9];
    a.ffn_w_gate = (const float*)d_in[10]; a.ffn_w_up = (const float*)d_in[11]; a.ffn_w_down = (const float*)d_in[12]; a.router_w = (const float*)d_in[13];
    a.moe_w_gate = (const float*)d_in[14]; a.moe_w_up = (const float*)d_in[15]; a.moe_w_down = (const float*)d_in[16]; a.ln_ffn_g = (const float*)d_in[17]; a.ln_ffn_b = (const float*)d_in[18];
    a.out = (float*)d_out; a.ws = (unsigned char*)d_ws; a.pad = 0;
#if MK_ONE_LAUNCH
    a.ph_lo = 0; a.ph_hi = N_PHASES; a.li = 0;
    hipLaunchKernelGGL(fwd_kernel, dim3(grid), dim3(NWAVES * 64), LDS_BYTES, stream, a);
#else
    for (int p = 0; p < N_PHASES; ++p) { a.ph_lo = p; a.ph_hi = p + 1; a.li = p;
        hipLaunchKernelGGL(fwd_kernel, dim3(grid), dim3(NWAVES * 64), LDS_BYTES, stream, a); }
#endif
}
```
